# Optimizing an MI355X kernel written in HIP

```python
import math
import jax, jax.numpy as jnp
from jax import lax
import numpy as np

D_MODEL = 2048
BATCH = 4
SEQ = 4096
DEPTH = 2

HEAD_DIM = 128
N_HEADS = D_MODEL // HEAD_DIM
N_HEADS_FOX = N_HEADS // 2
N_HEADS_DIL = N_HEADS - N_HEADS_FOX
D_FOX = N_HEADS_FOX * HEAD_DIM
D_DIL = N_HEADS_DIL * HEAD_DIM
D_MIX = D_FOX + D_DIL
SPLIT_SIZES = (D_FOX, D_FOX, D_FOX, N_HEADS_FOX, D_DIL, D_DIL, D_DIL)
SPLIT_POINTS = tuple(int(s) for s in np.cumsum(SPLIT_SIZES)[:-1])
N_IN = int(sum(SPLIT_SIZES))
D_FF = 4 * D_MODEL
Q_BLOCK = 128
DIL_PATTERNS = ((128, 1), (512, 4), (2048, 16))
DIL_BLOCK = 128
REL_BUCKETS = 32
REL_MAX_DISTANCE = 2048
NORM_EPS = 1e-6
NEG_INF = -1e30

kernel_name = "hymba_fox_dilated_hybrid"


def rms_norm(x, g):
    xf = x.astype(jnp.float32)
    y = xf * lax.rsqrt(jnp.mean(xf * xf, axis=-1, keepdims=True) + NORM_EPS)
    return (y * g.astype(jnp.float32)).astype(x.dtype)


def fox_attention(q, k, v, log_f):
    B, S, H, E = q.shape
    scale = E ** -0.5
    c = jnp.cumsum(log_f, axis=1).transpose(0, 2, 1)
    qh = q.transpose(0, 2, 1, 3)
    kh = k.transpose(0, 2, 1, 3)
    vh = v.transpose(0, 2, 1, 3)
    k_pos = jnp.arange(S)
    n_blk = S // Q_BLOCK

    def block(i):
        start = i * Q_BLOCK
        qb = lax.dynamic_slice_in_dim(qh, start, Q_BLOCK, axis=2)
        cb = lax.dynamic_slice_in_dim(c, start, Q_BLOCK, axis=2)
        logits = jnp.einsum('bhqe,bhke->bhqk', qb, kh,
                            preferred_element_type=jnp.float32) * scale
        logits = logits + (cb[..., :, None] - c[..., None, :])
        q_pos = start + jnp.arange(Q_BLOCK)
        causal = k_pos[None, :] <= q_pos[:, None]
        logits = jnp.where(causal, logits, NEG_INF)
        p = jax.nn.softmax(logits, axis=-1)
        return jnp.einsum('bhqk,bhke->bqhe', p.astype(v.dtype), vh)

    out = lax.map(block, jnp.arange(n_blk))
    return out.transpose(1, 0, 2, 3, 4).reshape(B, S, H, E)


def rel_bucket(dist):
    max_exact = REL_BUCKETS // 2
    d = jnp.maximum(dist.astype(jnp.float32), 1.0)
    large = max_exact + (jnp.log(d / max_exact) / math.log(REL_MAX_DISTANCE / max_exact)
                         * (REL_BUCKETS - max_exact)).astype(jnp.int32)
    large = jnp.minimum(large, REL_BUCKETS - 1)
    return jnp.where(dist < max_exact, dist, large)


def dilated_pattern(q, k, v, rel_bias, window, dilation):
    B, S, H, E = q.shape
    scale = E ** -0.5
    span = window // dilation
    group = dilation * DIL_BLOCK
    s_pad = -(-S // group) * group
    pad = s_pad - S
    n_sub = s_pad // dilation
    n_blk = n_sub // DIL_BLOCK

    def to_blocks(t):
        t = jnp.pad(t, ((0, 0), (0, pad), (0, 0), (0, 0)))
        t = t.reshape(B, n_sub, dilation, H, E).transpose(0, 2, 3, 1, 4)
        return t.reshape(B, dilation, H, n_blk, DIL_BLOCK, E)

    def with_prev(t):
        prev = jnp.pad(t, ((0, 0), (0, 0), (0, 0), (1, 0), (0, 0), (0, 0)))[:, :, :, :-1]
        return jnp.concatenate([prev, t], axis=4)

    qb = to_blocks(q)
    kc = with_prev(to_blocks(k))
    vc = with_prev(to_blocks(v))
    logits = jnp.einsum('bdhnqe,bdhnke->bdhnqk', qb, kc,
                        preferred_element_type=jnp.float32) * scale
    i = jnp.arange(DIL_BLOCK)[:, None]
    j = jnp.arange(2 * DIL_BLOCK)[None, :]
    rel = DIL_BLOCK + i - j
    in_band = (rel >= 0) & (rel <= span)
    bias = rel_bias.astype(jnp.float32)[rel_bucket(jnp.clip(rel, 0, span) * dilation)]
    bias = bias.transpose(2, 0, 1)
    key_valid = (jnp.arange(n_blk)[:, None, None] > 0) | (j[None] >= DIL_BLOCK)
    mask = in_band[None] & key_valid
    logits = logits + bias[None, None, :, None]
    logits = jnp.where(mask[None, None, None], logits, NEG_INF)
    m = jnp.max(logits, axis=-1, keepdims=True)
    p = jnp.exp(logits - m)
    s = jnp.sum(p, axis=-1, keepdims=True)
    o = jnp.einsum('bdhnqk,bdhnke->bdhnqe', p, vc.astype(jnp.float32)) / s
    lse = (m + jnp.log(s))[..., 0]

    def from_blocks(t):
        tail = t.shape[5:]
        t = t.reshape((B, dilation, H, n_sub) + tail)
        t = jnp.moveaxis(t, 3, 1)
        return t.reshape((B, s_pad, H) + tail)[:, :S]

    return from_blocks(o), from_blocks(lse)


def dilated_attention(q, k, v, rel_bias):
    outs, lses = [], []
    for window, dilation in DIL_PATTERNS:
        o, l = dilated_pattern(q, k, v, rel_bias, window, dilation)
        outs.append(o)
        lses.append(l)
    alpha = jax.nn.softmax(jnp.stack(lses, axis=0), axis=0)
    return jnp.einsum('pbsh,pbshe->bshe', alpha, jnp.stack(outs, axis=0))


def setup_inputs(seed: int = 0) -> dict:
    key = jax.random.key(seed)
    ks = jax.random.split(key, 12)
    f32 = jnp.float32
    return {
        "x": jax.random.normal(ks[0], (BATCH, SEQ, D_MODEL), f32),
        "norm1_g": 1.0 + 0.02 * jax.random.normal(ks[1], (DEPTH, D_MODEL), f32),
        "w_in": jax.random.normal(ks[2], (DEPTH, D_MODEL, N_IN), f32) * D_MODEL ** -0.5,
        "forget_b": jax.random.uniform(ks[3], (DEPTH, N_HEADS_FOX), f32, 1.0, 4.0),
        "rel_bias": 0.5 * jax.random.normal(ks[4], (REL_BUCKETS, N_HEADS_DIL), f32),
        "outnorm_a_g": 1.0 + 0.02 * jax.random.normal(ks[5], (DEPTH, D_FOX), f32),
        "outnorm_b_g": 1.0 + 0.02 * jax.random.normal(ks[6], (DEPTH, D_DIL), f32),
        "w_out": jax.random.normal(ks[7], (DEPTH, D_MIX, D_MODEL), f32) * D_MIX ** -0.5,
        "norm2_g": 1.0 + 0.02 * jax.random.normal(ks[8], (DEPTH, D_MODEL), f32),
        "w_mlp_in": jax.random.normal(ks[9], (DEPTH, D_MODEL, D_FF), f32) * D_MODEL ** -0.5,
        "w_mlp_out": jax.random.normal(ks[10], (DEPTH, D_FF, D_MODEL), f32) * D_FF ** -0.5,
        "final_norm_g": 1.0 + 0.02 * jax.random.normal(ks[11], (D_MODEL,), f32),
    }


def reference(x, norm1_g, w_in, forget_b, rel_bias, outnorm_a_g, outnorm_b_g, w_out,
              norm2_g, w_mlp_in, w_mlp_out, final_norm_g):
    B, S, _ = x.shape
    for l in range(DEPTH):
        h = rms_norm(x, norm1_g[l])
        proj = h @ w_in[l]
        q_a, k_a, v_a, f_a, q_b, k_b, v_b = jnp.split(proj, SPLIT_POINTS, axis=-1)
        heads_a = lambda t: t.reshape(B, S, N_HEADS_FOX, HEAD_DIM)
        heads_b = lambda t: t.reshape(B, S, N_HEADS_DIL, HEAD_DIM)
        log_f = jax.nn.log_sigmoid(f_a.astype(jnp.float32) + forget_b[l].astype(jnp.float32))
        y_a = fox_attention(heads_a(q_a), heads_a(k_a), heads_a(v_a), log_f)
        y_a = y_a.reshape(B, S, D_FOX)
        y_b = dilated_attention(heads_b(q_b), heads_b(k_b), heads_b(v_b), rel_bias)
        y_b = y_b.reshape(B, S, D_DIL).astype(x.dtype)
        mixed = jnp.concatenate([rms_norm(y_a, outnorm_a_g[l]),
                                 rms_norm(y_b, outnorm_b_g[l])], axis=-1)
        x = x + mixed @ w_out[l]
        h = rms_norm(x, norm2_g[l])
        x = x + jnp.square(jax.nn.relu(h @ w_mlp_in[l])) @ w_mlp_out[l]
    return rms_norm(x, final_norm_g)
```

```cpp
#include <hip/hip_runtime.h>
#include <hip/hip_cooperative_groups.h>
#include <hip/hip_bf16.h>
#include <cstdio>
#include <cstdint>
#include <cmath>
#ifndef PHASES
#define PHASES 511
#endif
namespace pg8 {
#define PG8_LAS __attribute__((address_space(3)))
typedef unsigned short bf16_t;
typedef short bf16x8 __attribute__((ext_vector_type(8)));
typedef float f32x4 __attribute__((ext_vector_type(4)));
typedef unsigned u32x4 __attribute__((ext_vector_type(4)));
constexpr int BM = 256, BK = 64, HALF = 128, HTB = HALF * BK * 2  , STAGE_BYTES = 8 * HTB, NXCD = 8, WGM = 8;

__host__ __device__ __forceinline__ int lds_byte(int r, int c) { const int st = (r >> 4) * 2 + (c >> 5), rr = r & 15, cc = c & 31, ob = rr * 64 + cc * 2; return st * 1024 + (ob ^ (((ob >> 9) & 1) << 5)); }
__host__ __device__ __forceinline__ void stage_rc(int b, int& R, int& C) { const int st = b / 1024, sb = b % 1024, swz = sb ^ (((sb >> 9) & 1) << 5); R = (st >> 1) * 16 + swz / 64; C = (st & 1) * 32 + (swz % 64) / 2; }
__host__ __device__ __forceinline__ int perm32(int rho) { const int n = rho >> 4, i = rho & 15; return 8 * (i >> 2) + 4 * n + (i & 3); }

struct Unit { int pm, pn; };
struct Gemm { const bf16_t* A; const bf16_t* Bt; int M, N, K; };

struct StaticOrder {
    int nM, nN, nwg, G, c;
    __host__ __device__ void init(int M, int N, int G_, int c_) { nM = M / BM; nN = N / BM; nwg = nM * nN; G = G_; c = c_; }
    __host__ __device__ bool next(int i, Unit& u) const {
        const long L = (long)i * G + c; if (L >= nwg) return false;
        int wgid = (int)L; { const int q = nwg / NXCD, r = nwg % NXCD, xcd = wgid % NXCD, off = wgid / NXCD; wgid = (xcd < r ? xcd * (q + 1) : r * (q + 1) + (xcd - r) * q) + off; }
        const int nig = WGM * nN, gid = wgid / nig, fm = gid * WGM, gsz = (nM - fm) < WGM ? (nM - fm) : WGM;
        u.pm = fm + ((wgid % nig) % gsz); u.pn = (wgid % nig) / gsz; return true;
    }
    __device__ __forceinline__ void a_ready(const Unit&) const {}
    __device__ __forceinline__ void done(const Unit&) const {}
};

__device__ __forceinline__ unsigned cvt_pk_bf16(float lo, float hi) { unsigned r; asm volatile("v_cvt_pk_bf16_f32 %0, %1, %2" : "=v"(r) : "v"(lo), "v"(hi)); return r; }
typedef float f32x2 __attribute__((ext_vector_type(2)));
__device__ __forceinline__ f32x2 gelu_pk(f32x2 v) {
    const f32x2 av = __builtin_elementwise_abs(v), d = av * 0.2316418882f + 1.0f;
    f32x2 t; t.x = __builtin_amdgcn_rcpf(d.x); t.y = __builtin_amdgcn_rcpf(d.y);
    f32x2 q = t * 0.5307027145f + (-0.7265760135f); q = q * t + 0.7107068705f; q = q * t + (-0.142248368f); q = q * t + 0.127414796f; q = q * t;
    const f32x2 s = (v * v) * (-0.72134752044f);
    f32x2 e; e.x = __builtin_amdgcn_exp2f(s.x); e.y = __builtin_amdgcn_exp2f(s.y);
    const f32x2 m = v * (q * e), r = v - m;
    f32x2 o; o.x = v.x < 0.f ? m.x : r.x; o.y = v.y < 0.f ? m.y : r.y; return o;
}

template <int ACT  > struct EpiBf16 {
    static constexpr bool PERM = true, AFTER_DRAIN = false; static_assert(ACT == 0 || ACT == 1 || ACT == 2, "EpiBf16: ACT is 0 (none), 1 (gelu_pk) or 2 (squared relu)");
    bf16_t* O; int ldc; const float* bias; int split_cols; size_t split_stride; float scale0;
    __device__ __forceinline__ void operator()(const f32x4 (&acc)[2][2][4][2], const Unit& u, int wr, int wc, int fr, int fq) const {
        const int row0 = u.pm * BM + wr * 64 + fr; int colt = u.pn * BM; bf16_t* base = O;
        float sc = 1.f; if (split_cols) { const int t = colt / split_cols; base += (size_t)t * split_stride; colt -= t * split_cols; if (t == 0) sc = scale0; }
        const int col0 = colt + wc * 32 + 8 * fq, bcol0 = u.pn * BM + wc * 32 + 8 * fq;
        f32x4 bv[2][2];
#pragma unroll
        for (int bj = 0; bj < 2; ++bj)
#pragma unroll
            for (int n = 0; n < 2; ++n) bv[bj][n] = bias ? *(const f32x4*)(bias + bcol0 + bj * HALF + 4 * n) : (f32x4){0.f, 0.f, 0.f, 0.f};
#pragma unroll
        for (int ai = 0; ai < 2; ++ai)
#pragma unroll
            for (int m = 0; m < 4; ++m) { bf16_t* rowp = base + (size_t)(row0 + ai * HALF + m * 16) * ldc + col0;
#pragma unroll
                for (int bj = 0; bj < 2; ++bj) { f32x4 v0 = acc[ai][bj][m][0] + bv[bj][0], v1 = acc[ai][bj][m][1] + bv[bj][1];
                    if (ACT == 1) { f32x2 a = gelu_pk((f32x2){v0[0], v0[1]}), b = gelu_pk((f32x2){v0[2], v0[3]}), c = gelu_pk((f32x2){v1[0], v1[1]}), d = gelu_pk((f32x2){v1[2], v1[3]});
                        v0 = (f32x4){a.x, a.y, b.x, b.y}; v1 = (f32x4){c.x, c.y, d.x, d.y}; }
                    if (ACT == 2) { v0 = __builtin_elementwise_max(v0, (f32x4){0.f, 0.f, 0.f, 0.f}); v1 = __builtin_elementwise_max(v1, (f32x4){0.f, 0.f, 0.f, 0.f}); v0 = v0 * v0; v1 = v1 * v1; }
                    v0 = v0 * sc; v1 = v1 * sc; u32x4 w; w.x = cvt_pk_bf16(v0[0], v0[1]); w.y = cvt_pk_bf16(v0[2], v0[3]); w.z = cvt_pk_bf16(v1[0], v1[1]); w.w = cvt_pk_bf16(v1[2], v1[3]);
                    *(u32x4*)(rowp + bj * HALF) = w; } }
    }
};

struct EpiResF32 {
    static constexpr bool PERM = false, AFTER_DRAIN = false;
    const float* base; float* out; int ldc;
    __device__ __forceinline__ void operator()(const f32x4 (&acc)[2][2][4][2], const Unit& u, int wr, int wc, int fr, int fq) const {
        const int col0 = u.pn * BM + wc * 32 + 4 * fq;
#pragma unroll
        for (int ai = 0; ai < 2; ++ai)
#pragma unroll
            for (int m = 0; m < 4; ++m) { const size_t off = (size_t)(u.pm * BM + ai * HALF + wr * 64 + m * 16 + fr) * ldc + col0;
                f32x4 bs[2][2];
#pragma unroll
                for (int bj = 0; bj < 2; ++bj)
#pragma unroll
                    for (int n = 0; n < 2; ++n) bs[bj][n] = *(const f32x4*)(base + off + bj * HALF + n * 16);
#pragma unroll
                for (int bj = 0; bj < 2; ++bj)
#pragma unroll
                    for (int n = 0; n < 2; ++n) *(f32x4*)(out + off + bj * HALF + n * 16) = bs[bj][n] + acc[ai][bj][m][n];
            }
    }
};
template <class Epi, class Sched, bool ALIGN_EPI = false, bool SP2 = false>
__device__ __forceinline__ void gemm_phase(PG8_LAS unsigned char* lds, const Gemm g, const Sched& S, const Epi& E) {
    int tid = threadIdx.x; asm volatile("" : "+v"(tid));
    const int wid = __builtin_amdgcn_readfirstlane(tid >> 6), lane = tid & 63, wr = wid >> 2, wc = wid & 3, fr = lane & 15, fq = lane >> 4;
    const int K = g.K, nt = K / BK;
    unsigned voffA[2], voffB[2];
#pragma unroll
    for (int i = 0; i < 2; ++i) { int R, C; stage_rc(tid * 16 + i * 8192, R, C); const int Rb = Epi::PERM ? ((R & ~31) + perm32(R & 31)) : R;
        voffA[i] = (unsigned)(R * K + C) * 2u; voffB[i] = (unsigned)(Rb * K + C) * 2u; }
    const size_t kstep = (size_t)(BK * 2);
    const size_t hstep = (size_t)HALF * K * 2;
    const size_t tstep = 2 * hstep;
    const unsigned ldsw = (unsigned)wid * 1024u;
    const int aoff = lds_byte(wr * 64 + fr, fq * 8), boff = lds_byte(wc * 32 + fr, fq * 8);
#define PG8_SA(b, h) (((b) * 2 + (h)) * HTB)
#define PG8_SB(b, h) ((4 + (b) * 2 + (h)) * HTB)
#define PG8_STAGE(bufoff, gbase, voff) do { _Pragma("unroll") for (int _i = 0; _i < 2; ++_i) \
        __builtin_amdgcn_global_load_lds((const unsigned*)((const char*)(gbase) + (voff)[_i]), (PG8_LAS unsigned*)(lds + (bufoff) + ldsw + _i * 8192), 16, 0, 0); } while (0)
#define PG8_LDA(dst, b, h) do { _Pragma("unroll") for (int m = 0; m < 4; ++m) _Pragma("unroll") for (int k = 0; k < 2; ++k) dst[m][k] = *(const PG8_LAS bf16x8*)(lds + PG8_SA(b, h) + aoff + m * 2048 + k * 1024); } while (0)
#define PG8_LDB(dst, b, h) do { _Pragma("unroll") for (int n = 0; n < 2; ++n) _Pragma("unroll") for (int k = 0; k < 2; ++k) dst[n][k] = *(const PG8_LAS bf16x8*)(lds + PG8_SB(b, h) + boff + n * 2048 + k * 1024); } while (0)
#define PG8_MMA(ai, bj, At, Bt) do { __builtin_amdgcn_s_setprio(1); _Pragma("unroll") for (int m = 0; m < 4; ++m) _Pragma("unroll") for (int n = 0; n < 2; ++n) _Pragma("unroll") for (int k = 0; k < 2; ++k) \
        acc[ai][bj][m][n] = __builtin_amdgcn_mfma_f32_16x16x32_bf16(Bt[n][k], At[m][k], acc[ai][bj][m][n], 0, 0, 0); __builtin_amdgcn_s_setprio(0); } while (0)
#define PG8_WAIT_V(n) asm volatile("s_waitcnt vmcnt(" #n ")" ::: "memory")
#define PG8_WAIT_L(n) asm volatile("s_waitcnt lgkmcnt(" #n ")" ::: "memory")
#define PG8_BAR __builtin_amdgcn_s_barrier()
#define PG8_SCHED __builtin_amdgcn_sched_barrier(0)
    Unit cur, nxt; int ui = 0;
    if (!S.next(0, cur)) return;
    f32x4 acc[2][2][4][2];
#pragma unroll
    for (int a = 0; a < 2; ++a)
#pragma unroll
        for (int b = 0; b < 2; ++b)
#pragma unroll
            for (int m = 0; m < 4; ++m)
#pragma unroll
                for (int n = 0; n < 2; ++n) acc[a][b][m][n] = (f32x4){0.f, 0.f, 0.f, 0.f};
    bf16x8 At[4][2], B0[2][2], B1[2][2];
    const char* cA = (const char*)g.A + (size_t)cur.pm * tstep; const char* cB = (const char*)g.Bt + (size_t)cur.pn * tstep;
    S.a_ready(cur);
    if constexpr (SP2) {
        PG8_STAGE(PG8_SB(0, 0), cB, voffB); PG8_STAGE(PG8_SB(0, 1), cB + hstep, voffB); PG8_STAGE(PG8_SA(0, 0), cA, voffA); PG8_STAGE(PG8_SA(0, 1), cA + hstep, voffA);
        if (wr == 1) PG8_BAR;
        PG8_WAIT_V(2); PG8_BAR;
        PG8_STAGE(PG8_SB(1, 0), cB + kstep, voffB); PG8_STAGE(PG8_SA(1, 0), cA + kstep, voffA); PG8_STAGE(PG8_SB(1, 1), cB + hstep + kstep, voffB);
        PG8_WAIT_V(6); PG8_BAR;
    } else {
        PG8_STAGE(PG8_SB(0, 0), cB, voffB); PG8_STAGE(PG8_SA(0, 0), cA, voffA); PG8_STAGE(PG8_SB(0, 1), cB + hstep, voffB); PG8_STAGE(PG8_SA(0, 1), cA + hstep, voffA);
        if (wr == 1) PG8_BAR;
        PG8_WAIT_V(4); PG8_BAR;
        PG8_STAGE(PG8_SB(1, 0), cB + kstep, voffB); PG8_STAGE(PG8_SA(1, 0), cA + kstep, voffA); PG8_STAGE(PG8_SB(1, 1), cB + hstep + kstep, voffB);
        PG8_WAIT_V(6); PG8_BAR;
    }
    for (;;) {
        const bool has_next = S.next(ui + 1, nxt);
        const char* nA = has_next ? (const char*)g.A + (size_t)nxt.pm * tstep : cA; const char* nB = has_next ? (const char*)g.Bt + (size_t)nxt.pn * tstep : cB;
        for (int t = 0; t < nt; t += 2) {
            const bool last = (t == nt - 2);
            const char* a1 = cA + (size_t)(t + 1) * kstep;
            const char* a2 = last ? nA : cA + (size_t)(t + 2) * kstep; const char* b2 = last ? nB : cB + (size_t)(t + 2) * kstep;
            const char* a3 = a2 + kstep; const char* b3 = b2 + kstep;
            if (last && has_next) S.a_ready(nxt);
            if constexpr (SP2) {
            PG8_LDB(B0, 0, 0); PG8_LDB(B1, 0, 1); PG8_SCHED; PG8_LDA(At, 0, 0); PG8_STAGE(PG8_SA(1, 1), a1 + hstep, voffA);
            PG8_WAIT_V(8); PG8_WAIT_L(0); PG8_BAR; PG8_MMA(0, 0, At, B0); PG8_MMA(0, 1, At, B1); PG8_BAR; PG8_SCHED;
            PG8_LDA(At, 0, 1); PG8_STAGE(PG8_SB(0, 0), b2, voffB); PG8_STAGE(PG8_SB(0, 1), b2 + hstep, voffB); PG8_STAGE(PG8_SA(0, 0), a2, voffA);
            PG8_WAIT_V(8); PG8_WAIT_L(0); PG8_BAR; PG8_MMA(1, 0, At, B0); PG8_MMA(1, 1, At, B1); PG8_BAR; PG8_SCHED;
            PG8_LDB(B0, 1, 0); PG8_LDB(B1, 1, 1); PG8_SCHED; PG8_LDA(At, 1, 0); PG8_STAGE(PG8_SA(0, 1), a2 + hstep, voffA);
            PG8_WAIT_V(8); PG8_WAIT_L(0); PG8_BAR; PG8_MMA(0, 0, At, B0); PG8_MMA(0, 1, At, B1); PG8_BAR; PG8_SCHED;
            PG8_LDA(At, 1, 1); PG8_STAGE(PG8_SB(1, 0), b3, voffB); PG8_STAGE(PG8_SB(1, 1), b3 + hstep, voffB); PG8_STAGE(PG8_SA(1, 0), a3, voffA);
            PG8_WAIT_V(8); PG8_WAIT_L(0); PG8_BAR; PG8_MMA(1, 0, At, B0); PG8_MMA(1, 1, At, B1); PG8_BAR; PG8_SCHED;
            } else {
            PG8_LDB(B0, 0, 0); PG8_SCHED; PG8_LDA(At, 0, 0); PG8_STAGE(PG8_SA(1, 1), a1 + hstep, voffA);
            PG8_WAIT_L(8); PG8_BAR; PG8_WAIT_L(0); PG8_MMA(0, 0, At, B0); PG8_BAR; PG8_SCHED;
            PG8_LDB(B1, 0, 1); PG8_STAGE(PG8_SB(0, 0), b2, voffB);
            PG8_BAR; PG8_WAIT_L(0); PG8_MMA(0, 1, At, B1); PG8_BAR;
            PG8_LDA(At, 0, 1); PG8_STAGE(PG8_SA(0, 0), a2, voffA);
            PG8_BAR; PG8_WAIT_L(0); PG8_MMA(1, 0, At, B0); PG8_BAR; PG8_SCHED;
            PG8_STAGE(PG8_SB(0, 1), b2 + hstep, voffB);
            PG8_WAIT_V(6); PG8_BAR; PG8_MMA(1, 1, At, B1); PG8_BAR;
            PG8_LDB(B0, 1, 0); PG8_SCHED; PG8_LDA(At, 1, 0); PG8_STAGE(PG8_SA(0, 1), a2 + hstep, voffA);
            PG8_WAIT_L(8); PG8_BAR; PG8_WAIT_L(0); PG8_MMA(0, 0, At, B0); PG8_BAR; PG8_SCHED;
            PG8_LDB(B1, 1, 1); PG8_STAGE(PG8_SB(1, 0), b3, voffB);
            PG8_BAR; PG8_WAIT_L(0); PG8_MMA(0, 1, At, B1); PG8_BAR;
            PG8_LDA(At, 1, 1); PG8_STAGE(PG8_SA(1, 0), a3, voffA);
            PG8_BAR; PG8_WAIT_L(0); PG8_MMA(1, 0, At, B0); PG8_BAR; PG8_SCHED;
            PG8_STAGE(PG8_SB(1, 1), b3 + hstep, voffB);
            PG8_WAIT_V(6); PG8_BAR; PG8_MMA(1, 1, At, B1); PG8_BAR;
            }
        }
        if constexpr (ALIGN_EPI) { if (wr == 0) PG8_BAR; }
        if constexpr (!Epi::AFTER_DRAIN) { E(acc, cur, wr, wc, fr, fq); S.done(cur); }
        if (!has_next) break;
#pragma unroll
        for (int a = 0; a < 2; ++a)
#pragma unroll
            for (int b = 0; b < 2; ++b)
#pragma unroll
                for (int m = 0; m < 4; ++m)
#pragma unroll
                    for (int n = 0; n < 2; ++n) acc[a][b][m][n] = (f32x4){0.f, 0.f, 0.f, 0.f};
        cur = nxt; cA = nA; cB = nB; ++ui;
        if constexpr (ALIGN_EPI) { if (wr == 1) PG8_BAR; }
    }
    PG8_WAIT_V(0);
    if constexpr (!ALIGN_EPI) { if (wr == 0) PG8_BAR; }
    PG8_BAR;
    if constexpr (Epi::AFTER_DRAIN) { E.fused(acc, cur, wr, wc, fr, fq, lds, wid, lane); S.done(cur); }
#undef PG8_SA
#undef PG8_SB
#undef PG8_STAGE
#undef PG8_LDA
#undef PG8_LDB
#undef PG8_MMA
#undef PG8_WAIT_V
#undef PG8_WAIT_L
#undef PG8_BAR
#undef PG8_SCHED
}
}
namespace swa {
constexpr int D = 128;
constexpr float THR = 8.f;
constexpr float SCALE = 0.08838834764831845f;
constexpr int NW = 8, QBLK = 32, KVBLK = 64, QB = NW * QBLK;
constexpr int SHM_V = KVBLK * D * 2, SHM_K = KVBLK * D * 2;
constexpr int OFF_WS = 2 * SHM_V + 2 * SHM_K;
constexpr int OFF_CS = OFF_WS + NW * 64 * 4;
constexpr int OFF_SC = OFF_CS + 4096 * 8;
constexpr int LDS_BYTES = OFF_SC + 64;
constexpr int TABN = 320, TABOFF = 96;

using bf16 = __hip_bfloat16;
typedef short bf16x8 __attribute__((ext_vector_type(8)));
typedef short s16x4 __attribute__((ext_vector_type(4)));
typedef float f32x16 __attribute__((ext_vector_type(16)));
typedef float f32x4 __attribute__((ext_vector_type(4)));
typedef unsigned u32x4 __attribute__((ext_vector_type(4)));
typedef unsigned u32x2 __attribute__((ext_vector_type(2)));

#define KSWZ(row, colB) ((row) * 256 + ((colB) ^ (((row) & 7) << 4)))
#define SBAR() __builtin_amdgcn_sched_barrier(0)
__device__ __forceinline__ int v_st(int k, int c) { const int kk = (k & ~0xC) | ((k & 4) << 1) | ((k & 8) >> 1); return ((kk >> 3) * 4 + (c >> 5)) * 512 + ((kk & 7) * 32 + (c & 31)) * 2; }
__device__ __forceinline__ int v_rd_base(int lane) { return ((lane & 3) << 3) | (((lane >> 2) & 3) << 6) | (((lane >> 4) & 1) << 5) | (((lane >> 5) & 1) << 8); }
constexpr int v_rd_off(int d0, int ks, int half) { return d0 * 512 + ks * 4096 + half * 2048; }
__device__ __forceinline__ int crow(int r, int hi) { return (r & 3) + 8 * (r >> 2) + 4 * hi; }
__device__ __forceinline__ unsigned cvtpk(float lo, float hi) { unsigned r; asm volatile("v_cvt_pk_bf16_f32 %0, %1, %2" : "=v"(r) : "v"(lo), "v"(hi)); return r; }
__device__ __forceinline__ bf16x8 load8(const bf16* p) { return *reinterpret_cast<const bf16x8*>(p); }

__device__ __forceinline__ void mask_tile(f32x16& p0, f32x16& p1, int dq, unsigned W) {
    const float NEG = -__builtin_inff();
#pragma unroll
    for (int r = 0; r < 16; ++r) {
        const int c = (r & 3) + 8 * (r >> 2);
        if ((unsigned)(dq - c) >= W) p0[r] = NEG;
        if ((unsigned)(dq - c - 32) >= W) p1[r] = NEG;
    }
}
__device__ __forceinline__ void bias_mask_tile(f32x16& p0, f32x16& p1, int dq, unsigned W, const float* tab) {
    const float NEG = -__builtin_inff();
    const float* tb = tab + TABOFF + dq;
#pragma unroll
    for (int q = 0; q < 4; ++q) {
#pragma unroll
        for (int e = 0; e < 4; ++e) { const int r = 4 * q + e, c = e + 8 * q;
            const float b0 = tb[-c], b1 = tb[-c - 32];
            p0[r] = ((unsigned)(dq - c) >= W) ? NEG : p0[r] + b0;
            p1[r] = ((unsigned)(dq - c - 32) >= W) ? NEG : p1[r] + b1; }
        asm volatile("" ::: "memory");
    }
}
__device__ __forceinline__ void partialSM(f32x16& p0, f32x16& p1, float& m_reg, float& mn, float& alpha) {
    float pmax = p0[0]; for (int r = 1; r < 16; ++r) pmax = fmaxf(pmax, p0[r]); for (int r = 0; r < 16; ++r) pmax = fmaxf(pmax, p1[r]);
    { auto rr = __builtin_amdgcn_permlane32_swap(__float_as_uint(pmax), __float_as_uint(pmax), false, false);
      pmax = fmaxf(__uint_as_float(rr[0]), __uint_as_float(rr[1])); }
    constexpr float C2 = 1.4426950408889634f * SCALE;
    if (__builtin_expect(__all((pmax - m_reg) * SCALE <= THR), 1)) { mn = m_reg; alpha = 1.f; }
    else { mn = fmaxf(m_reg, pmax); alpha = __builtin_amdgcn_exp2f((m_reg - mn) * C2); m_reg = mn; }
    const float mnL = -mn * C2;
    for (int r = 0; r < 16; ++r) p0[r] = fmaf(p0[r], C2, mnL); for (int r = 0; r < 16; ++r) p1[r] = fmaf(p1[r], C2, mnL);
    for (int r = 0; r < 16; ++r) p0[r] = __builtin_amdgcn_exp2f(p0[r]);
}
__device__ __forceinline__ void finishSM(f32x16& p0, f32x16& p1, float alpha, float& l_reg, bf16x8& pa0, bf16x8& pa1, bf16x8& pa2, bf16x8& pa3) {
    for (int r = 0; r < 16; ++r) p1[r] = __builtin_amdgcn_exp2f(p1[r]);
    float ps = 0; for (int r = 0; r < 16; ++r) ps += p0[r]; for (int r = 0; r < 16; ++r) ps += p1[r];
    { auto rr = __builtin_amdgcn_permlane32_swap(__float_as_uint(ps), __float_as_uint(ps), false, false);
      ps = __uint_as_float(rr[0]) + __uint_as_float(rr[1]); }
    l_reg = l_reg * alpha + ps;
#define PK4(P, B_, OUT) do { unsigned a0 = cvtpk(P[B_+0], P[B_+1]), a1 = cvtpk(P[B_+2], P[B_+3]);                          \
        unsigned b0 = cvtpk(P[B_+4], P[B_+5]), b1 = cvtpk(P[B_+6], P[B_+7]);                                             \
        auto r0 = __builtin_amdgcn_permlane32_swap(a0, b0, false, false); auto r1 = __builtin_amdgcn_permlane32_swap(a1, b1, false, false); \
        u32x4 w = {r0[0], r1[0], r0[1], r1[1]}; OUT = *reinterpret_cast<bf16x8*>(&w); } while (0)
    PK4(p0, 0, pa0); PK4(p0, 8, pa1); PK4(p1, 0, pa2); PK4(p1, 8, pa3);
#undef PK4
}
template <int KB, bool SK, int MODE>
__device__ __forceinline__ void qkt(f32x16& p0, f32x16& p1, const char* K_lds, int r32, int hi, const bf16x8* qr, bool act, const unsigned long long* csk, bf16x8 qx) {
    if (SK && !act) { const float NEG = -__builtin_inff();
#pragma unroll
        for (int r = 0; r < 16; ++r) { p0[r] = NEG; p1[r] = NEG; } return; }
    p0 = f32x16{}; p1 = f32x16{};
    if constexpr (MODE == 1) {
        const u32x2 t0 = *(const u32x2*)(csk), t1 = *(const u32x2*)(csk + 32);
        const u32x4 k0 = {t0.x, t0.y, 0x3f803f80u, 0x00003f80u}, k1 = {t1.x, t1.y, 0x3f803f80u, 0x00003f80u};
        p0 = __builtin_amdgcn_mfma_f32_32x32x16_bf16(__builtin_bit_cast(bf16x8, k0), qx, p0, 0, 0, 0);
        p1 = __builtin_amdgcn_mfma_f32_32x32x16_bf16(__builtin_bit_cast(bf16x8, k1), qx, p1, 0, 0, 0);
    }
    const char* kb[4];
#pragma unroll
    for (int dd = 0; dd < 4; ++dd) kb[dd] = K_lds + KB * SHM_K + KSWZ(r32, (dd * 16 + hi * 8) * 2);
#pragma unroll
    for (int d0 = 0; d0 < 8; ++d0) { const char* a = kb[d0 & 3] + (d0 >> 2) * 128;
        bf16x8 b0 = *reinterpret_cast<const bf16x8*>(a);
        bf16x8 b1 = *reinterpret_cast<const bf16x8*>(a + 32 * 256);
        p0 = __builtin_amdgcn_mfma_f32_32x32x16_bf16(b0, qr[d0], p0, 0, 0, 0);
        p1 = __builtin_amdgcn_mfma_f32_32x32x16_bf16(b1, qr[d0], p1, 0, 0, 0); }
}
template <int VB, bool SK>
__device__ __forceinline__ void pv_tile(f32x16* o, int vb0, bf16x8 pa0, bf16x8 pa1, bf16x8 pa2, bf16x8 pa3, bool act) {
    if (SK && !act) return;
#define TRRD(dst, off) asm volatile("ds_read_b64_tr_b16 %0, %1 offset:%2" : "=&v"(dst) : "v"(vb0), "i"(off) : "memory")
#define PV_D0(d0) do { s16x4 l0, l1, l2, l3, h0, h1, h2, h3; constexpr int b_ = VB * SHM_V + v_rd_off(d0, 0, 0); \
        TRRD(l0, b_); TRRD(h0, b_ + 2048); TRRD(l1, b_ + 4096); TRRD(h1, b_ + 6144); TRRD(l2, b_ + 8192); TRRD(h2, b_ + 10240); TRRD(l3, b_ + 12288); TRRD(h3, b_ + 14336); \
        asm volatile("s_waitcnt lgkmcnt(0)" ::: "memory"); SBAR();   \
        o[d0] = __builtin_amdgcn_mfma_f32_32x32x16_bf16(pa0, (bf16x8){l0[0], l0[1], l0[2], l0[3], h0[0], h0[1], h0[2], h0[3]}, o[d0], 0, 0, 0);   \
        o[d0] = __builtin_amdgcn_mfma_f32_32x32x16_bf16(pa1, (bf16x8){l1[0], l1[1], l1[2], l1[3], h1[0], h1[1], h1[2], h1[3]}, o[d0], 0, 0, 0);   \
        o[d0] = __builtin_amdgcn_mfma_f32_32x32x16_bf16(pa2, (bf16x8){l2[0], l2[1], l2[2], l2[3], h2[0], h2[1], h2[2], h2[3]}, o[d0], 0, 0, 0);   \
        o[d0] = __builtin_amdgcn_mfma_f32_32x32x16_bf16(pa3, (bf16x8){l3[0], l3[1], l3[2], l3[3], h3[0], h3[1], h3[2], h3[3]}, o[d0], 0, 0, 0); } while (0)
    PV_D0(0); PV_D0(1); PV_D0(2); PV_D0(3);
#undef PV_D0
#undef TRRD
}

struct BlockRef { const bf16* Q; const bf16* K; const bf16* V; bf16* O; float* L; const float* aux; int P0, skv, W, pad; };
__device__ __forceinline__ int swa_jlo(int P0, int W) { const int lowk = P0 - W + 1; return lowk > 0 ? lowk / KVBLK : 0; }
#define ROW(p, k0, rr0, rs_) ((const bf16*)((const char*)(p) + (size_t)((k0) + (rr0)) * (size_t)(rs_) * 2 + voff))
#define VMW() asm volatile("s_waitcnt vmcnt(0)" ::: "memory")
#define SLOAD_H(Kp, Vp, k0, rs_) do { st_v0 = load8(ROW(Vp, k0, 0, rs_)); st_v1 = load8(ROW(Vp, k0, 32, rs_));              \
                         st_k0 = load8(ROW(Kp, k0, 0, rs_)); st_k1 = load8(ROW(Kp, k0, 32, rs_)); } while (0)
#define SWRITE_HK(bf) do { *(bf16x8*)(K_lds + (bf) * SHM_K + kws) = st_k0; *(bf16x8*)(K_lds + (bf) * SHM_K + kws + 32 * 256) = st_k1; } while (0)
#define SWRITE_HV(bf) do { *(bf16x8*)(V_lds + (bf) * SHM_V + vst0) = st_v0; *(bf16x8*)(V_lds + (bf) * SHM_V + vst1) = st_v1; } while (0)
#define SWRITE_H(bf) do { SWRITE_HV(bf); SWRITE_HK(bf); } while (0)
template <int MODE, bool SK, int RS>
__device__ __forceinline__ void swa_block(const BlockRef& cur, char* lds) {
    int tid = threadIdx.x; asm volatile("" : "+v"(tid));
    const int wid = __builtin_amdgcn_readfirstlane(tid >> 6), lane = tid & 63, r32 = lane & 31, hi = lane >> 5;
    const int W = cur.W, skv = cur.skv; constexpr int rs = RS;
    const int j_lo = swa_jlo(cur.P0, W);
    int j_hi = (cur.P0 + QB - 1) / KVBLK + 1; if (j_hi > skv / KVBLK) j_hi = skv / KVBLK;
    const int NT = j_hi - j_lo;
    const int qlo = cur.P0 + wid * QBLK, qm = qlo + r32 - 4 * hi;
    char* V_lds = lds; char* K_lds = lds + 2 * SHM_V;
    float* ws = (float*)(lds + OFF_WS) + wid * 64; float* li_l = ws, * al_l = ws + 32;
    const int sr = tid >> 4, sc = (tid & 15) * 8, vst0 = v_st(sr, sc), vst1 = v_st(32 + sr, sc), kws = KSWZ(sr, sc * 2);
    const unsigned voff = (unsigned)(sr * RS + sc) * 2u, qoff = (unsigned)(r32 * RS + hi * 8) * 2u;
    const int vb0 = (int)(uintptr_t)V_lds + v_rd_base(lane);
    const bf16* Kh = cur.K; const bf16* Vh = cur.V;
    bf16x8 qr[8], st_v0, st_v1, st_k0, st_k1;
#define KBASE(t) ((j_lo + (t)) * KVBLK)
    { const char* qb_ = (const char*)(cur.Q + (size_t)(cur.P0 + wid * QBLK) * RS);
#pragma unroll
      for (int d0 = 0; d0 < 8; ++d0) qr[d0] = load8((const bf16*)(qb_ + qoff + d0 * 32)); }
    SLOAD_H(Kh, Vh, KBASE(0), RS);
    bf16x8 qx = {};
    unsigned long long* cs = (unsigned long long*)(lds + OFF_CS);
    if constexpr (MODE == 1) {
        float* sc8 = (float*)(lds + OFF_SC);
        const int n = cur.P0 + QB; const float* lf = cur.aux;
        f32x4 a = {0.f, 0.f, 0.f, 0.f}, b = {0.f, 0.f, 0.f, 0.f};
        if (8 * tid < n) { a = *(const f32x4*)(lf + 8 * tid); b = *(const f32x4*)(lf + 8 * tid + 4); }
        a[1] += a[0]; a[2] += a[1]; a[3] += a[2]; b[0] += a[3]; b[1] += b[0]; b[2] += b[1]; b[3] += b[2];
        const float tot = b[3]; float inc = tot;
#pragma unroll
        for (int o_ = 1; o_ < 64; o_ <<= 1) { const float v = __shfl_up(inc, o_); if (lane >= o_) inc += v; }
        if (lane == 63) sc8[wid] = inc;
        __syncthreads();
        float base = inc - tot;
        for (int w = 0; w < wid; ++w) base += sc8[w];
        const float ninv = -1.f / SCALE;
        if (8 * tid < n) {
#pragma unroll
            for (int e = 0; e < 8; ++e) { const float v = ((e < 4 ? a[e & 3] : b[e & 3]) + base) * ninv;
                const unsigned h = cvtpk(v, 0.f) & 0xffffu; const float r1 = v - __uint_as_float(h << 16);
                const unsigned m = cvtpk(r1, 0.f) & 0xffffu; const float r2 = r1 - __uint_as_float(m << 16);
                const unsigned lo = cvtpk(r2, 0.f) & 0xffffu;
                cs[8 * tid + e] = (unsigned long long)(h | (m << 16)) | ((unsigned long long)lo << 32); }
        }
        __syncthreads();
        const unsigned long long tq = cs[cur.P0 + wid * QBLK + r32];
        const u32x4 qv = {0x3f803f80u, 0x00003f80u, (unsigned)tq ^ 0x80008000u, (unsigned)(tq >> 32) ^ 0x00008000u};
        qx = hi ? bf16x8{} : __builtin_bit_cast(bf16x8, qv);
    }
    if constexpr (MODE == 2) { if (tid < TABN) ((float*)cs)[tid] = cur.aux[tid]; }
    VMW(); SWRITE_H(0);
    __syncthreads();
    float m_reg = -1e30f, l_reg = 0; f32x16 o[4] = {};
#define RESC(a) do { if (__any((a) < 1.f)) { if (hi == 0) al_l[r32] = (a); asm volatile("s_waitcnt lgkmcnt(0)" ::: "memory");              \
                     for (int d_ = 0; d_ < 4; ++d_) for (int r = 0; r < 16; ++r) o[d_][r] *= al_l[crow(r, hi)]; } } while (0)
#define ACT(t) (KBASE(t) <= qlo + QBLK - 1 && KBASE(t) + KVBLK - 1 >= qlo - W + 1)
#define MASKT(P0_, P1_, t) do { const int kb_ = KBASE(t); \
        if constexpr (MODE == 2) { bias_mask_tile(P0_, P1_, qm - kb_, (unsigned)W, (const float*)cs); } \
        else { if (kb_ + KVBLK - 1 > qlo || kb_ <= qlo + QBLK - 1 - W) mask_tile(P0_, P1_, qm - kb_, (unsigned)W); } } while (0)
#define CSK(t) (cs + KBASE(t) + r32)
#define TILE(t, BUF) do { \
        if ((t) + 1 < NT) { SLOAD_H(Kh, Vh, KBASE((t) + 1), RS); } SBAR(); \
        if (!SK || ACT(t)) { f32x16 p0, p1; float mn, al; bf16x8 pa0, pa1, pa2, pa3; \
            qkt<BUF, false, MODE>(p0, p1, K_lds, r32, hi, qr, true, CSK(t), qx); \
            MASKT(p0, p1, t); partialSM(p0, p1, m_reg, mn, al); RESC(al); \
            finishSM(p0, p1, al, l_reg, pa0, pa1, pa2, pa3); SBAR(); \
            pv_tile<BUF, false>(o, vb0, pa0, pa1, pa2, pa3, true); } \
        SBAR(); \
        if ((t) + 1 < NT) { VMW(); SWRITE_H((BUF) ^ 1); } \
        __syncthreads(); } while (0)
    for (int t = 0; t < NT; t += 2) { TILE(t, 0); TILE(t + 1, 1); }
    if (hi == 0) li_l[r32] = l_reg; asm volatile("s_waitcnt lgkmcnt(0)" ::: "memory");
    float rli[16];
#pragma unroll
    for (int r = 0; r < 16; ++r) rli[r] = __builtin_amdgcn_rcpf(li_l[crow(r, hi)]);
    char* Ow = (char*)(cur.O + (size_t)(cur.P0 + wid * QBLK) * rs);
    const unsigned ooff = (unsigned)(4 * hi * rs + r32) * 2u;
#pragma unroll
    for (int r = 0; r < 16; ++r) { const unsigned orow = (unsigned)(((r & 3) + 8 * (r >> 2)) * rs) * 2u;
#pragma unroll
        for (int d0 = 0; d0 < 4; ++d0) { const float v = o[d0][r] * rli[r];
            const float vn = __shfl_xor(v, 1);
            if ((r32 & 1) == 0) *(unsigned*)(Ow + ooff + orow + d0 * 64) = cvtpk(v, vn); } }
    if constexpr (MODE == 2) { if (hi == 0) cur.L[(size_t)(cur.P0 + wid * QBLK + r32) * (RS / 128)] = m_reg * SCALE + __logf(l_reg); }
    __syncthreads();
#undef RESC
#undef KBASE
#undef ACT
#undef MASKT
#undef CSK
#undef TILE
}
#undef ROW
#undef VMW
#undef SLOAD_H
#undef SWRITE_HK
#undef SWRITE_HV
#undef SWRITE_H
#undef KSWZ
#undef SBAR
}
namespace cg = cooperative_groups;
constexpr int NWAVES = 8;
constexpr int BATCH = 4, SEQ = 4096, DM = 2048, DEPTH = 2, NHF = 8, HD = 128, DH = 1024, NIN = 6152, DFF = 8192;
constexpr int M = BATCH * SEQ;
constexpr int NQKV = 6 * DH;
constexpr float NORM_EPS = 1e-6f;
constexpr size_t MiB = 1u << 20;
constexpr size_t WS_LF = 1 * MiB;
constexpr size_t WS_BT = 1 * MiB + 768 * 1024;
constexpr size_t WS_LSE = 2 * MiB;
constexpr size_t WS_WIN = 4 * MiB, WS_WOUT = 28 * MiB, WS_W1 = 36 * MiB, WS_W2 = 68 * MiB;
constexpr size_t WS_XN = 100 * MiB;
constexpr size_t WS_QKV = 164 * MiB;
constexpr size_t WS_OP = 356 * MiB;
constexpr size_t WS_YA = 452 * MiB;
constexpr size_t WS_H = 164 * MiB;
constexpr size_t WS_END = 484 * MiB;
constexpr int LDS_BYTES = 147456;

#define GAS __attribute__((address_space(1)))
#define LAS __attribute__((address_space(3)))
typedef unsigned short bf16r;
typedef unsigned v4u __attribute__((ext_vector_type(4)));
typedef unsigned v2u __attribute__((ext_vector_type(2)));
typedef float f32x4 __attribute__((ext_vector_type(4)));
#define LDS_WAIT() asm volatile("s_waitcnt lgkmcnt(0)" ::: "memory")
__device__ __forceinline__ unsigned f2bf(float f) { unsigned u = __builtin_bit_cast(unsigned, f); return (u + 0x7fffu + ((u >> 16) & 1u)) >> 16; }
__device__ __forceinline__ unsigned pk2(float lo, float hi) { return f2bf(lo) | (f2bf(hi) << 16); }
__device__ __forceinline__ float bf2f(unsigned short h) { return __builtin_bit_cast(float, (unsigned)h << 16); }
__device__ __forceinline__ float wave_sum(float v) {
#pragma unroll
    for (int o = 1; o < 64; o <<= 1) v += __shfl_xor(v, o);
    return v;
}

struct Args { const float* in[12]; float* out; unsigned char* ws; };

__device__ __forceinline__ void transpose_item(const float* W, int K, int ldw, int c0, int N, bf16r* WT, int row_off, LAS float* scr, int item, int lane) {
    const int nblk = N / 32, kb = item / nblk, nb = item % nblk, k0 = 64 * kb, n0 = 32 * nb;
#pragma unroll 8
    for (int i = 0; i < 32; ++i) { const int kk = 2 * i + (lane >> 5); scr[kk * 33 + (lane & 31)] = W[(size_t)(k0 + kk) * ldw + c0 + n0 + (lane & 31)]; }
    LDS_WAIT(); asm volatile("" ::: "memory");
    const int c = lane & 7;
#pragma unroll
    for (int j = 0; j < 4; ++j) { const int n = (lane >> 3) + 8 * j; const LAS float* s = scr + (8 * c) * 33 + n;
        v4u o; o.x = pk2(s[0 * 33], s[1 * 33]); o.y = pk2(s[2 * 33], s[3 * 33]); o.z = pk2(s[4 * 33], s[5 * 33]); o.w = pk2(s[6 * 33], s[7 * 33]);
        *(v4u*)(WT + (size_t)(row_off + n0 + n) * K + k0 + 8 * c) = o; }
    LDS_WAIT(); asm volatile("" ::: "memory");
}

__device__ __forceinline__ int t5_bucket(int dist) {
    if (dist < 16) return dist;
    const int thr[15] = {22, 30, 40, 54, 73, 99, 134, 182, 246, 332, 450, 609, 825, 1117, 1513};
    int b = 16;
#pragma unroll
    for (int i = 0; i < 15; ++i) b += (dist >= thr[i]) ? 1 : 0;
    return b;
}

__global__ void __launch_bounds__(NWAVES * 64, 2) hymba_fwd(Args args) {
    extern __shared__ __attribute__((aligned(16))) unsigned char lds[];
    cg::grid_group grid = cg::this_grid();
    const int G = gridDim.x, bx = blockIdx.x;
    const int vcu = (G % 8 == 0) ? (bx % 8) * (G / 8) + bx / 8 : bx;
    const int NGW = G * NWAVES;
#define PHASE_IDS() int tid = threadIdx.x; asm volatile("" : "+v"(tid)); const int lane = tid & 63, wave = __builtin_amdgcn_readfirstlane(tid >> 6), gw = vcu * NWAVES + wave; (void)lane; (void)gw
    unsigned char* ws = args.ws;
    const float* x_in = args.in[0]; const float* norm1_g = args.in[1]; const float* w_in = args.in[2]; const float* forget_b = args.in[3];
    const float* rel_bias = args.in[4]; const float* ona_g = args.in[5]; const float* onb_g = args.in[6]; const float* w_out = args.in[7];
    const float* norm2_g = args.in[8]; const float* w_mlp_in = args.in[9]; const float* w_mlp_out = args.in[10]; const float* final_g = args.in[11];
    float* XR = args.out;
    float* LF = (float*)(ws + WS_LF); float* BT = (float*)(ws + WS_BT); float* LSE = (float*)(ws + WS_LSE);
    bf16r* Win_t = (bf16r*)(ws + WS_WIN); bf16r* Wout_t = (bf16r*)(ws + WS_WOUT); bf16r* W1_t = (bf16r*)(ws + WS_W1); bf16r* W2_t = (bf16r*)(ws + WS_W2);
    bf16r* XN = (bf16r*)(ws + WS_XN); bf16r* QKV = (bf16r*)(ws + WS_QKV); bf16r* OP = (bf16r*)(ws + WS_OP); bf16r* YA = (bf16r*)(ws + WS_YA); bf16r* HB = (bf16r*)(ws + WS_H);
    constexpr size_t QSTR = (size_t)M * DH;

    { PHASE_IDS();
    for (int i = gw * 64 + lane; i < 3 * 8 * swa::TABN; i += NGW * 64) {
        const int e = i % swa::TABN, h = (i / swa::TABN) % 8, p = i / (swa::TABN * 8), rel = e - swa::TABOFF, dil = (p == 0) ? 1 : (p == 1) ? 4 : 16;
        BT[i] = (rel >= 0 && rel <= 128) ? rel_bias[t5_bucket(rel * dil) * 8 + h] * (1.f / swa::SCALE) : 0.f;
    }
    }

#pragma unroll 1
    for (int l = 0; l < DEPTH; ++l) {
        const float* xsrc = (l == 0) ? x_in : XR;
#if PHASES & 1
        {
            PHASE_IDS();
            LAS float* scr = (LAS float*)(lds) + wave * 4096;
            const float* Wi = w_in + (size_t)l * DM * NIN; const float* Wo = w_out + (size_t)l * DM * DM;
            const float* Wa = w_mlp_in + (size_t)l * DM * DFF; const float* Wb = w_mlp_out + (size_t)l * DFF * DM;
            constexpr int I_S = (DM / 64) * (DH / 32), I_O = (DM / 64) * (DM / 32), I_1 = (DM / 64) * (DFF / 32), I_2 = (DFF / 64) * (DM / 32);
            constexpr int NITEMS = 6 * I_S + I_O + I_1 + I_2;
            for (int it = gw; it < NITEMS; it += NGW) {
                int r = it;
                if (r < 6 * I_S) { const int s = r / I_S; const int c0 = s * DH + (s >= 3 ? 8 : 0); transpose_item(Wi, DM, NIN, c0, DH, Win_t, s * DH, scr, r % I_S, lane); continue; } r -= 6 * I_S;
                if (r < I_O) { transpose_item(Wo, DM, DM, 0, DM, Wout_t, 0, scr, r, lane); continue; } r -= I_O;
                if (r < I_1) { transpose_item(Wa, DM, DFF, 0, DFF, W1_t, 0, scr, r, lane); continue; } r -= I_1;
                transpose_item(Wb, DFF, DM, 0, DM, W2_t, 0, scr, r, lane);
            }
            __syncthreads();
            LAS f32x4* wf = (LAS f32x4*)lds;
            const float* g1 = norm1_g + (size_t)l * DM;
            for (int k = tid; k < DM; k += NWAVES * 64) {
                const float gk = g1[k]; const float* src = Wi + (size_t)k * NIN + 3 * DH;
                const f32x4 a = *(const f32x4*)src, b = *(const f32x4*)(src + 4);
                const int j = k >> 8, ln = (k & 255) >> 2, e = k & 3;
                wf[((j * 4 + e) * 2 + 0) * 64 + ln] = a * gk; wf[((j * 4 + e) * 2 + 1) * 64 + ln] = b * gk;
            }
            __syncthreads();
            const float* fb = forget_b + l * NHF;
            for (int m = gw; m < M; m += NGW) {
                const f32x4* xr = (const f32x4*)(xsrc + (size_t)m * DM) + lane;
                f32x4 v[8]; float ss = 0.f;
#pragma unroll
                for (int j = 0; j < 8; ++j) { v[j] = xr[64 * j]; ss += (v[j].x * v[j].x + v[j].y * v[j].y) + (v[j].z * v[j].z + v[j].w * v[j].w); }
                f32x4 fa = {0.f, 0.f, 0.f, 0.f}, fbv = {0.f, 0.f, 0.f, 0.f};
#pragma unroll
                for (int j = 0; j < 8; ++j) {
#pragma unroll
                    for (int e = 0; e < 4; ++e) { const float xv = v[j][e]; fa += wf[((j * 4 + e) * 2 + 0) * 64 + lane] * xv; fbv += wf[((j * 4 + e) * 2 + 1) * 64 + lane] * xv; }
                    asm volatile("" ::: "memory"); }
                const float rstd = 1.f / sqrtf(wave_sum(ss) * (1.f / DM) + NORM_EPS);
                float f8[8];
#pragma unroll
                for (int e = 0; e < 4; ++e) { f8[e] = wave_sum(fa[e]); f8[4 + e] = wave_sum(fbv[e]); }
                float fsel = f8[0];
#pragma unroll
                for (int e = 1; e < 8; ++e) fsel = (lane == e) ? f8[e] : fsel;
                if (lane < 8) { const float z = fsel * rstd + fb[lane]; const float ls = fminf(z, 0.f) - log1pf(__expf(-fabsf(z)));
                    LF[((size_t)(m / SEQ) * NHF + lane) * SEQ + (m % SEQ)] = ls; }
                const f32x4* gr = (const f32x4*)g1 + lane;
                v2u* o8 = (v2u*)(XN + (size_t)m * DM) + lane;
#pragma unroll
                for (int j = 0; j < 8; ++j) { const f32x4 g = gr[64 * j]; v2u w; w.x = pk2(v[j].x * rstd * g.x, v[j].y * rstd * g.y); w.y = pk2(v[j].z * rstd * g.z, v[j].w * rstd * g.w); o8[64 * j] = w; }
            }
        }
#endif
        grid.sync();
#if PHASES & 2
        {
            pg8::Gemm g{XN, Win_t, M, NQKV, DM}; pg8::StaticOrder S; S.init(M, NQKV, G, bx);
            pg8::EpiBf16<0> E{QKV, DH, nullptr, DH, QSTR, 1.f};
            pg8::gemm_phase<pg8::EpiBf16<0>, pg8::StaticOrder, true, true>((LAS unsigned char*)lds, g, S, E);
        }
#endif
        grid.sync();
        {
            const swa::bf16* Qa = (const swa::bf16*)QKV; const swa::bf16* Ka = Qa + QSTR; const swa::bf16* Va = Qa + 2 * QSTR;
            const swa::bf16* Qb = Qa + 3 * QSTR; const swa::bf16* Kb = Qa + 4 * QSTR; const swa::bf16* Vb = Qa + 5 * QSTR;
#if PHASES & 4
            {
                const int nitems = (vcu < 256) ? (255 - vcu) / G + 1 : 0, nblk = 2 * nitems;
                auto ref = [&](int k) { const int item = vcu + (k >> 1) * G, bh = item >> 3, y = item & 7, qb = (k & 1) ? 15 - y : y, b = bh >> 3, h = bh & 7;
                    const size_t off = (size_t)b * SEQ * DH + h * HD;
                    swa::BlockRef r; r.Q = Qa + off; r.K = Ka + off; r.V = Va + off; r.O = (swa::bf16*)YA + off; r.L = nullptr; r.aux = LF + (size_t)bh * SEQ;
                    r.P0 = qb * 256; r.skv = SEQ; r.W = 1 << 30; r.pad = 0; return r; };
                for (int k = 0; k < nblk; ++k) { const swa::BlockRef cur = ref(k); swa::swa_block<1, false, DH>(cur, (char*)lds); }
            }
#endif
#if PHASES & 8
#define DIL_STREAM(P_, DIL_) do { constexpr int NB = 512; const int per = (NB + G - 1) / G, first = vcu * per, last = (first + per < NB) ? first + per : NB; \
                auto ref = [&](int g) { const int bh = (g >> 4) & 31, j = g & 15, b = bh >> 3, h = bh & 7; constexpr int nbr = 16 / DIL_; const int res = j / nbr, blk = j % nbr; \
                    const size_t off = ((size_t)b * SEQ + res) * DH + h * HD; \
                    swa::BlockRef r; r.Q = Qb + off; r.K = Kb + off; r.V = Vb + off; r.O = (swa::bf16*)OP + (size_t)P_ * QSTR + off; \
                    r.L = LSE + ((size_t)P_ * M + (size_t)b * SEQ + res) * 8 + h; r.aux = BT + (size_t)(P_ * 8 + h) * swa::TABN; \
                    r.P0 = blk * 256; r.skv = SEQ / DIL_; r.W = 129; r.pad = 0; return r; }; \
                for (int g = first; g < last; ++g) { const swa::BlockRef cur = ref(g); swa::swa_block<2, true, DH * DIL_>(cur, (char*)lds); } } while (0)
            DIL_STREAM(0, 1); DIL_STREAM(1, 4); DIL_STREAM(2, 16);
#undef DIL_STREAM
#endif
        }
        grid.sync();
#if PHASES & 16
        {
            PHASE_IDS();
            const float* ga = ona_g + (size_t)l * DH; const float* gb = onb_g + (size_t)l * DH;
            for (int m = gw; m < M; m += NGW) {
                const int h = lane >> 3;
                const float l0 = LSE[((size_t)0 * M + m) * 8 + h], l1 = LSE[((size_t)1 * M + m) * 8 + h], l2 = LSE[((size_t)2 * M + m) * 8 + h];
                const float mx = fmaxf(l0, fmaxf(l1, l2)); float a0 = __expf(l0 - mx), a1 = __expf(l1 - mx), a2 = __expf(l2 - mx);
                const float inv = 1.f / (a0 + a1 + a2); a0 *= inv; a1 *= inv; a2 *= inv;
                const v4u* ya = (const v4u*)(YA + (size_t)m * DH) + 2 * lane;
                const v4u* o0 = (const v4u*)(OP + (size_t)m * DH) + 2 * lane; const v4u* o1 = (const v4u*)(OP + QSTR + (size_t)m * DH) + 2 * lane; const v4u* o2 = (const v4u*)(OP + 2 * QSTR + (size_t)m * DH) + 2 * lane;
                float va[16], vb[16]; float sa = 0.f, sb = 0.f;
#pragma unroll
                for (int q = 0; q < 2; ++q) { const v4u ua = ya[q], u0 = o0[q], u1 = o1[q], u2 = o2[q];
#pragma unroll
                    for (int e = 0; e < 4; ++e) {
                        const float alo = __builtin_bit_cast(float, ua[e] << 16), ahi = __builtin_bit_cast(float, ua[e] & 0xffff0000u);
                        const float blo = a0 * __builtin_bit_cast(float, u0[e] << 16) + a1 * __builtin_bit_cast(float, u1[e] << 16) + a2 * __builtin_bit_cast(float, u2[e] << 16);
                        const float bhi = a0 * __builtin_bit_cast(float, u0[e] & 0xffff0000u) + a1 * __builtin_bit_cast(float, u1[e] & 0xffff0000u) + a2 * __builtin_bit_cast(float, u2[e] & 0xffff0000u);
                        va[q * 8 + 2 * e] = alo; va[q * 8 + 2 * e + 1] = ahi; vb[q * 8 + 2 * e] = blo; vb[q * 8 + 2 * e + 1] = bhi;
                        sa += alo * alo + ahi * ahi; sb += blo * blo + bhi * bhi; } }
                const float ra = 1.f / sqrtf(wave_sum(sa) * (1.f / DH) + NORM_EPS), rb = 1.f / sqrtf(wave_sum(sb) * (1.f / DH) + NORM_EPS);
                const f32x4* gar = (const f32x4*)ga + 4 * lane; const f32x4* gbr = (const f32x4*)gb + 4 * lane;
                v4u* oa = (v4u*)(XN + (size_t)m * DM) + 2 * lane; v4u* ob = (v4u*)(XN + (size_t)m * DM + DH) + 2 * lane;
#pragma unroll
                for (int q = 0; q < 2; ++q) { const f32x4 g0 = gar[2 * q], g1 = gar[2 * q + 1], h0 = gbr[2 * q], h1 = gbr[2 * q + 1];
                    v4u wa, wb;
                    wa.x = pk2(va[q * 8 + 0] * ra * g0.x, va[q * 8 + 1] * ra * g0.y); wa.y = pk2(va[q * 8 + 2] * ra * g0.z, va[q * 8 + 3] * ra * g0.w);
                    wa.z = pk2(va[q * 8 + 4] * ra * g1.x, va[q * 8 + 5] * ra * g1.y); wa.w = pk2(va[q * 8 + 6] * ra * g1.z, va[q * 8 + 7] * ra * g1.w);
                    wb.x = pk2(vb[q * 8 + 0] * rb * h0.x, vb[q * 8 + 1] * rb * h0.y); wb.y = pk2(vb[q * 8 + 2] * rb * h0.z, vb[q * 8 + 3] * rb * h0.w);
                    wb.z = pk2(vb[q * 8 + 4] * rb * h1.x, vb[q * 8 + 5] * rb * h1.y); wb.w = pk2(vb[q * 8 + 6] * rb * h1.z, vb[q * 8 + 7] * rb * h1.w);
                    oa[q] = wa; ob[q] = wb; }
            }
        }
#endif
        grid.sync();
#if PHASES & 32
        {
            pg8::Gemm g{XN, Wout_t, M, DM, DM}; pg8::StaticOrder S; S.init(M, DM, G, bx);
            pg8::EpiResF32 E{xsrc, XR, DM};
            pg8::gemm_phase<pg8::EpiResF32, pg8::StaticOrder, true, true>((LAS unsigned char*)lds, g, S, E);
        }
#endif
        grid.sync();
#if PHASES & 64
        {
            PHASE_IDS();
            const float* g2 = norm2_g + (size_t)l * DM;
            for (int m = gw; m < M; m += NGW) {
                const f32x4* xr = (const f32x4*)(XR + (size_t)m * DM) + lane;
                f32x4 v[8]; float ss = 0.f;
#pragma unroll
                for (int j = 0; j < 8; ++j) { v[j] = xr[64 * j]; ss += (v[j].x * v[j].x + v[j].y * v[j].y) + (v[j].z * v[j].z + v[j].w * v[j].w); }
                const float rstd = 1.f / sqrtf(wave_sum(ss) * (1.f / DM) + NORM_EPS);
                const f32x4* gr = (const f32x4*)g2 + lane;
                v2u* o8 = (v2u*)(XN + (size_t)m * DM) + lane;
#pragma unroll
                for (int j = 0; j < 8; ++j) { const f32x4 g = gr[64 * j]; v2u w; w.x = pk2(v[j].x * rstd * g.x, v[j].y * rstd * g.y); w.y = pk2(v[j].z * rstd * g.z, v[j].w * rstd * g.w); o8[64 * j] = w; }
            }
        }
#endif
        grid.sync();
#if PHASES & 128
        {
            pg8::Gemm g{XN, W1_t, M, DFF, DM}; pg8::StaticOrder S; S.init(M, DFF, G, bx);
            pg8::EpiBf16<2> E{HB, DFF, nullptr, 0, 0, 1.f};
            pg8::gemm_phase<pg8::EpiBf16<2>, pg8::StaticOrder, true, true>((LAS unsigned char*)lds, g, S, E);
        }
#endif
        grid.sync();
#if PHASES & 256
        {
            pg8::Gemm g{HB, W2_t, M, DM, DFF}; pg8::StaticOrder S; S.init(M, DM, G, bx);
            pg8::EpiResF32 E{XR, XR, DM};
            pg8::gemm_phase<pg8::EpiResF32, pg8::StaticOrder, true, true>((LAS unsigned char*)lds, g, S, E);
        }
#endif
        grid.sync();
    }
    { PHASE_IDS();
    for (int m = gw; m < M; m += NGW) {
        f32x4* xr = (f32x4*)(XR + (size_t)m * DM) + lane;
        f32x4 v[8]; float ss = 0.f;
#pragma unroll
        for (int j = 0; j < 8; ++j) { v[j] = xr[64 * j]; ss += (v[j].x * v[j].x + v[j].y * v[j].y) + (v[j].z * v[j].z + v[j].w * v[j].w); }
        const float rstd = 1.f / sqrtf(wave_sum(ss) * (1.f / DM) + NORM_EPS);
        const f32x4* gr = (const f32x4*)final_g + lane;
#pragma unroll
        for (int j = 0; j < 8; ++j) xr[64 * j] = v[j] * rstd * gr[64 * j];
    }
    }
}

extern "C" void kernel_launch(void* const* d_in, const int* in_sizes, int n_in, void* d_out, int out_size, void* d_ws, size_t ws_size, hipStream_t stream) {
    static int grid = 0;
    if (grid == 0) {
        if (n_in != 12 || out_size != M * DM || ws_size < WS_END) { fprintf(stderr, "kernel_launch: unexpected shapes (n_in %d out %d ws %zu)\n", n_in, out_size, ws_size); grid = -1; return; }
        int dev = 0, cus = 0, per_cu = 0;
        (void)hipGetDevice(&dev); (void)hipDeviceGetAttribute(&cus, hipDeviceAttributeMultiprocessorCount, dev);
        if (hipFuncSetAttribute((const void*)hymba_fwd, hipFuncAttributeMaxDynamicSharedMemorySize, LDS_BYTES) != hipSuccess) { fprintf(stderr, "kernel_launch: hipFuncSetAttribute failed\n"); grid = -1; return; }
        if (hipOccupancyMaxActiveBlocksPerMultiprocessor(&per_cu, (const void*)hymba_fwd, NWAVES * 64, LDS_BYTES) != hipSuccess || per_cu < 1) { fprintf(stderr, "kernel_launch: occupancy query gives %d\n", per_cu); per_cu = 1; }
        (void)hipGetLastError();
        grid = cus * 1;
        if (grid <= 0) grid = 256;
    }
    if (grid < 0) return;
    Args a{};
    for (int i = 0; i < 12; ++i) a.in[i] = (const float*)d_in[i];
    a.out = (float*)d_out; a.ws = (unsigned char*)d_ws;
    void* kargs[] = {&a};
    hipError_t e = hipLaunchCooperativeKernel((const void*)hymba_fwd, dim3(grid), dim3(NWAVES * 64), kargs, LDS_BYTES, stream);
    if (e != hipSuccess) fprintf(stderr, "kernel_launch: cooperative launch failed: %s (grid %d)\n", hipGetErrorString(e), grid);
}
```

```cpp
#include <hip/hip_runtime.h>
#include <hip/hip_cooperative_groups.h>
#include <hip/hip_bf16.h>
#include <cstdio>
#include <cstdint>
#include <cmath>
#ifndef PHASES
#define PHASES 511
#endif
#ifndef REP0
#define REP0 1
#endif
#ifndef REP1
#define REP1 1
#endif
#ifndef REP2A
#define REP2A 1
#endif
#ifndef REP2B
#define REP2B 1
#endif
#ifndef REP3
#define REP3 1
#endif
#ifndef REP5
#define REP5 1
#endif
#ifndef REP6
#define REP6 1
#endif
#ifndef REP7
#define REP7 1
#endif
#ifndef REP4
#define REP4 1
#endif
#ifndef REPSYNC
#define REPSYNC 1
#endif
#ifndef REP6N
#define REP6N 1
#endif
__device__ __forceinline__ int fresh_lane() { unsigned z = 0u; asm volatile("" : "+s"(z)); return (int)__builtin_amdgcn_mbcnt_hi(~0u, __builtin_amdgcn_mbcnt_lo(~0u, z)); }
namespace pg8 {
#define PG8_LAS __attribute__((address_space(3)))
typedef unsigned short bf16_t;
typedef short bf16x8 __attribute__((ext_vector_type(8)));
typedef float f32x4 __attribute__((ext_vector_type(4)));
typedef unsigned u32x4 __attribute__((ext_vector_type(4)));
constexpr int BM = 256, BK = 64, HALF = 128, HTB = HALF * BK * 2  , STAGE_BYTES = 8 * HTB, NXCD = 8, WGM = 8;

__host__ __device__ __forceinline__ int lds_byte(int r, int c) { const int st = (r >> 4) * 2 + (c >> 5), rr = r & 15, cc = c & 31, ob = rr * 64 + cc * 2; return st * 1024 + (ob ^ (((ob >> 9) & 1) << 5)); }
__host__ __device__ __forceinline__ void stage_rc(int b, int& R, int& C) { const int st = b / 1024, sb = b % 1024, swz = sb ^ (((sb >> 9) & 1) << 5); R = (st >> 1) * 16 + swz / 64; C = (st & 1) * 32 + (swz % 64) / 2; }
__host__ __device__ __forceinline__ int perm32(int rho) { const int n = rho >> 4, i = rho & 15; return 8 * (i >> 2) + 4 * n + (i & 3); }

struct Unit { int pm, pn; };
struct Gemm { const bf16_t* A; const bf16_t* Bt; int M, N, K; };

struct StaticOrder {
    int nM, nN, nwg, G, c, wgm;
    __host__ __device__ void init(int M, int N, int G_, int c_, int wgm_ = WGM) { nM = M / BM; nN = N / BM; nwg = nM * nN; G = G_; c = c_; wgm = wgm_; }
    __host__ __device__ bool next(int i, Unit& u) const {
        const long L = (long)i * G + c; if (L >= nwg) return false;
        int wgid = (int)L; { const int q = nwg / NXCD, r = nwg % NXCD, xcd = wgid % NXCD, off = wgid / NXCD; wgid = (xcd < r ? xcd * (q + 1) : r * (q + 1) + (xcd - r) * q) + off; }
        const int nig = wgm * nN, gid = wgid / nig, fm = gid * wgm, gsz = (nM - fm) < wgm ? (nM - fm) : wgm;
        u.pm = fm + ((wgid % nig) % gsz); u.pn = (wgid % nig) / gsz; return true;
    }
    __device__ __forceinline__ void a_ready(const Unit&) const {}
    __device__ __forceinline__ void done(const Unit&) const {}
};

__device__ __forceinline__ unsigned cvt_pk_bf16(float lo, float hi) { unsigned r; asm volatile("v_cvt_pk_bf16_f32 %0, %1, %2" : "=v"(r) : "v"(lo), "v"(hi)); return r; }
typedef float f32x2 __attribute__((ext_vector_type(2)));
__device__ __forceinline__ f32x2 gelu_pk(f32x2 v) {
    const f32x2 av = __builtin_elementwise_abs(v), d = av * 0.2316418882f + 1.0f;
    f32x2 t; t.x = __builtin_amdgcn_rcpf(d.x); t.y = __builtin_amdgcn_rcpf(d.y);
    f32x2 q = t * 0.5307027145f + (-0.7265760135f); q = q * t + 0.7107068705f; q = q * t + (-0.142248368f); q = q * t + 0.127414796f; q = q * t;
    const f32x2 s = (v * v) * (-0.72134752044f);
    f32x2 e; e.x = __builtin_amdgcn_exp2f(s.x); e.y = __builtin_amdgcn_exp2f(s.y);
    const f32x2 m = v * (q * e), r = v - m;
    f32x2 o; o.x = v.x < 0.f ? m.x : r.x; o.y = v.y < 0.f ? m.y : r.y; return o;
}

template <int ACT  > struct EpiBf16 {
    static constexpr bool PERM = true, AFTER_DRAIN = false; static_assert(ACT == 0 || ACT == 1 || ACT == 2, "EpiBf16: ACT is 0 (none), 1 (gelu_pk) or 2 (squared relu)");
    bf16_t* O; int ldc; const float* bias; int split_cols; size_t split_stride; float scale0;
    __device__ __forceinline__ void operator()(const f32x4 (&acc)[2][2][4][2], const Unit& u, int wr, int wc, int fr, int fq) const {
        const int row0 = u.pm * BM + wr * 64 + fr; int colt = u.pn * BM; bf16_t* base = O;
        float sc = 1.f; if (split_cols) { const int t = colt / split_cols; base += (size_t)t * split_stride; colt -= t * split_cols; if (t == 0) sc = scale0; }
        const int col0 = colt + wc * 32 + 8 * fq, bcol0 = u.pn * BM + wc * 32 + 8 * fq;
        f32x4 bv[2][2];
#pragma unroll
        for (int bj = 0; bj < 2; ++bj)
#pragma unroll
            for (int n = 0; n < 2; ++n) bv[bj][n] = bias ? *(const f32x4*)(bias + bcol0 + bj * HALF + 4 * n) : (f32x4){0.f, 0.f, 0.f, 0.f};
#pragma unroll
        for (int ai = 0; ai < 2; ++ai)
#pragma unroll
            for (int m = 0; m < 4; ++m) { bf16_t* rowp = base + (size_t)(row0 + ai * HALF + m * 16) * ldc + col0;
#pragma unroll
                for (int bj = 0; bj < 2; ++bj) { f32x4 v0 = acc[ai][bj][m][0] + bv[bj][0], v1 = acc[ai][bj][m][1] + bv[bj][1];
                    if (ACT == 1) { f32x2 a = gelu_pk((f32x2){v0[0], v0[1]}), b = gelu_pk((f32x2){v0[2], v0[3]}), c = gelu_pk((f32x2){v1[0], v1[1]}), d = gelu_pk((f32x2){v1[2], v1[3]});
                        v0 = (f32x4){a.x, a.y, b.x, b.y}; v1 = (f32x4){c.x, c.y, d.x, d.y}; }
                    if (ACT == 2) { v0 = __builtin_elementwise_max(v0, (f32x4){0.f, 0.f, 0.f, 0.f}); v1 = __builtin_elementwise_max(v1, (f32x4){0.f, 0.f, 0.f, 0.f}); v0 = v0 * v0; v1 = v1 * v1; }
                    v0 = v0 * sc; v1 = v1 * sc; u32x4 w; w.x = cvt_pk_bf16(v0[0], v0[1]); w.y = cvt_pk_bf16(v0[2], v0[3]); w.z = cvt_pk_bf16(v1[0], v1[1]); w.w = cvt_pk_bf16(v1[2], v1[3]);
                    *(u32x4*)(rowp + bj * HALF) = w; } }
    }
};

struct EpiResF32 {
    static constexpr bool PERM = false, AFTER_DRAIN = false;
    const float* base; float* out; int ldc; float sc;
    __device__ __forceinline__ void operator()(const f32x4 (&acc)[2][2][4][2], const Unit& u, int wr, int wc, int fr, int fq) const {
        const int col0 = u.pn * BM + wc * 32 + 4 * fq;
#pragma unroll
        for (int ai = 0; ai < 2; ++ai)
#pragma unroll
            for (int m = 0; m < 4; ++m) { const size_t off = (size_t)(u.pm * BM + ai * HALF + wr * 64 + m * 16 + fr) * ldc + col0;
                f32x4 bs[2][2];
#pragma unroll
                for (int bj = 0; bj < 2; ++bj)
#pragma unroll
                    for (int n = 0; n < 2; ++n) bs[bj][n] = *(const f32x4*)(base + off + bj * HALF + n * 16);
#pragma unroll
                for (int bj = 0; bj < 2; ++bj)
#pragma unroll
                    for (int n = 0; n < 2; ++n) *(f32x4*)(out + off + bj * HALF + n * 16) = bs[bj][n] + acc[ai][bj][m][n] * sc;
            }
    }
};
struct EpiNull {
    static constexpr bool PERM = false, AFTER_DRAIN = false;
    __device__ __forceinline__ void operator()(const f32x4 (&acc)[2][2][4][2], const Unit& u, int wr, int wc, int fr, int fq) const {
        f32x4 s = {0.f, 0.f, 0.f, 0.f};
#pragma unroll
        for (int ai = 0; ai < 2; ++ai)
#pragma unroll
            for (int bj = 0; bj < 2; ++bj)
#pragma unroll
                for (int m = 0; m < 4; ++m)
#pragma unroll
                    for (int n = 0; n < 2; ++n) s += acc[ai][bj][m][n];
        asm volatile("" :: "v"(s));
    }
};
template <class Epi, class Sched, bool ALIGN_EPI = false, bool SP2 = false>
__device__ __forceinline__ void gemm_phase(PG8_LAS unsigned char* lds, const Gemm g, const Sched& S, const Epi& E, const int wave_u) {
    int tid = wave_u * 64 + fresh_lane(); asm volatile("" : "+v"(tid));
    const int wid = __builtin_amdgcn_readfirstlane(tid >> 6), lane = tid & 63, wr = wid >> 2, wc = wid & 3, fr = lane & 15, fq = lane >> 4;
    const int K = g.K, nt = K / BK;
    unsigned voffA[2], voffB[2];
#pragma unroll
    for (int i = 0; i < 2; ++i) { int R, C; stage_rc(tid * 16 + i * 8192, R, C); const int Rb = Epi::PERM ? ((R & ~31) + perm32(R & 31)) : R;
        voffA[i] = (unsigned)(R * K + C) * 2u; voffB[i] = (unsigned)(Rb * K + C) * 2u; }
    const size_t kstep = (size_t)(BK * 2);
    const size_t hstep = (size_t)HALF * K * 2;
    const size_t tstep = 2 * hstep;
    const unsigned ldsw = (unsigned)wid * 1024u;
    const int aoff = lds_byte(wr * 64 + fr, fq * 8), boff = lds_byte(wc * 32 + fr, fq * 8);
#define PG8_SA(b, h) (((b) * 2 + (h)) * HTB)
#define PG8_SB(b, h) ((4 + (b) * 2 + (h)) * HTB)
#define PG8_STAGE(bufoff, gbase, voff) do { _Pragma("unroll") for (int _i = 0; _i < 2; ++_i) \
        __builtin_amdgcn_global_load_lds((const unsigned*)((const char*)(gbase) + (voff)[_i]), (PG8_LAS unsigned*)(lds + (bufoff) + ldsw + _i * 8192), 16, 0, 0); } while (0)
#define PG8_LDA(dst, b, h) do { _Pragma("unroll") for (int m = 0; m < 4; ++m) _Pragma("unroll") for (int k = 0; k < 2; ++k) dst[m][k] = *(const PG8_LAS bf16x8*)(lds + PG8_SA(b, h) + aoff + m * 2048 + k * 1024); } while (0)
#define PG8_LDB(dst, b, h) do { _Pragma("unroll") for (int n = 0; n < 2; ++n) _Pragma("unroll") for (int k = 0; k < 2; ++k) dst[n][k] = *(const PG8_LAS bf16x8*)(lds + PG8_SB(b, h) + boff + n * 2048 + k * 1024); } while (0)
#define PG8_MMA(ai, bj, At, Bt) do { __builtin_amdgcn_s_setprio(1); _Pragma("unroll") for (int m = 0; m < 4; ++m) _Pragma("unroll") for (int n = 0; n < 2; ++n) _Pragma("unroll") for (int k = 0; k < 2; ++k) \
        acc[ai][bj][m][n] = __builtin_amdgcn_mfma_f32_16x16x32_bf16(Bt[n][k], At[m][k], acc[ai][bj][m][n], 0, 0, 0); __builtin_amdgcn_s_setprio(0); } while (0)
#define PG8_WAIT_V(n) asm volatile("s_waitcnt vmcnt(" #n ")" ::: "memory")
#define PG8_WAIT_L(n) asm volatile("s_waitcnt lgkmcnt(" #n ")" ::: "memory")
#define PG8_BAR __builtin_amdgcn_s_barrier()
#define PG8_SCHED __builtin_amdgcn_sched_barrier(0)
    Unit cur, nxt; int ui = 0;
    if (!S.next(0, cur)) return;
    f32x4 acc[2][2][4][2];
#pragma unroll
    for (int a = 0; a < 2; ++a)
#pragma unroll
        for (int b = 0; b < 2; ++b)
#pragma unroll
            for (int m = 0; m < 4; ++m)
#pragma unroll
                for (int n = 0; n < 2; ++n) acc[a][b][m][n] = (f32x4){0.f, 0.f, 0.f, 0.f};
    bf16x8 At[4][2], B0[2][2], B1[2][2];
    const char* cA = (const char*)g.A + (size_t)cur.pm * tstep; const char* cB = (const char*)g.Bt + (size_t)cur.pn * tstep;
    S.a_ready(cur);
    if constexpr (SP2) {
        PG8_STAGE(PG8_SB(0, 0), cB, voffB); PG8_STAGE(PG8_SB(0, 1), cB + hstep, voffB); PG8_STAGE(PG8_SA(0, 0), cA, voffA); PG8_STAGE(PG8_SA(0, 1), cA + hstep, voffA);
        if (wr == 1) PG8_BAR;
        PG8_WAIT_V(2); PG8_BAR;
        PG8_STAGE(PG8_SB(1, 0), cB + kstep, voffB); PG8_STAGE(PG8_SA(1, 0), cA + kstep, voffA); PG8_STAGE(PG8_SB(1, 1), cB + hstep + kstep, voffB);
        PG8_WAIT_V(6); PG8_BAR;
    } else {
        PG8_STAGE(PG8_SB(0, 0), cB, voffB); PG8_STAGE(PG8_SA(0, 0), cA, voffA); PG8_STAGE(PG8_SB(0, 1), cB + hstep, voffB); PG8_STAGE(PG8_SA(0, 1), cA + hstep, voffA);
        if (wr == 1) PG8_BAR;
        PG8_WAIT_V(4); PG8_BAR;
        PG8_STAGE(PG8_SB(1, 0), cB + kstep, voffB); PG8_STAGE(PG8_SA(1, 0), cA + kstep, voffA); PG8_STAGE(PG8_SB(1, 1), cB + hstep + kstep, voffB);
        PG8_WAIT_V(6); PG8_BAR;
    }
    for (;;) {
        const bool has_next = S.next(ui + 1, nxt);
        const char* nA = has_next ? (const char*)g.A + (size_t)nxt.pm * tstep : cA; const char* nB = has_next ? (const char*)g.Bt + (size_t)nxt.pn * tstep : cB;
        for (int t = 0; t < nt; t += 2) {
            const bool last = (t == nt - 2);
            const char* a1 = cA + (size_t)(t + 1) * kstep;
            const char* a2 = last ? nA : cA + (size_t)(t + 2) * kstep; const char* b2 = last ? nB : cB + (size_t)(t + 2) * kstep;
            const char* a3 = a2 + kstep; const char* b3 = b2 + kstep;
            if (last && has_next) S.a_ready(nxt);
            if constexpr (SP2) {
            PG8_LDB(B0, 0, 0); PG8_LDB(B1, 0, 1); PG8_SCHED; PG8_LDA(At, 0, 0); PG8_STAGE(PG8_SA(1, 1), a1 + hstep, voffA);
            PG8_WAIT_V(8); PG8_WAIT_L(0); PG8_BAR; PG8_MMA(0, 0, At, B0); PG8_MMA(0, 1, At, B1); PG8_BAR; PG8_SCHED;
            PG8_LDA(At, 0, 1); PG8_STAGE(PG8_SB(0, 0), b2, voffB); PG8_STAGE(PG8_SB(0, 1), b2 + hstep, voffB); PG8_STAGE(PG8_SA(0, 0), a2, voffA);
            PG8_WAIT_V(8); PG8_WAIT_L(0); PG8_BAR; PG8_MMA(1, 0, At, B0); PG8_MMA(1, 1, At, B1); PG8_BAR; PG8_SCHED;
            PG8_LDB(B0, 1, 0); PG8_LDB(B1, 1, 1); PG8_SCHED; PG8_LDA(At, 1, 0); PG8_STAGE(PG8_SA(0, 1), a2 + hstep, voffA);
            PG8_WAIT_V(8); PG8_WAIT_L(0); PG8_BAR; PG8_MMA(0, 0, At, B0); PG8_MMA(0, 1, At, B1); PG8_BAR; PG8_SCHED;
            PG8_LDA(At, 1, 1); PG8_STAGE(PG8_SB(1, 0), b3, voffB); PG8_STAGE(PG8_SB(1, 1), b3 + hstep, voffB); PG8_STAGE(PG8_SA(1, 0), a3, voffA);
            PG8_WAIT_V(8); PG8_WAIT_L(0); PG8_BAR; PG8_MMA(1, 0, At, B0); PG8_MMA(1, 1, At, B1); PG8_BAR; PG8_SCHED;
            } else {
            PG8_LDB(B0, 0, 0); PG8_SCHED; PG8_LDA(At, 0, 0); PG8_STAGE(PG8_SA(1, 1), a1 + hstep, voffA);
            PG8_WAIT_L(8); PG8_BAR; PG8_WAIT_L(0); PG8_MMA(0, 0, At, B0); PG8_BAR; PG8_SCHED;
            PG8_LDB(B1, 0, 1); PG8_STAGE(PG8_SB(0, 0), b2, voffB);
            PG8_BAR; PG8_WAIT_L(0); PG8_MMA(0, 1, At, B1); PG8_BAR;
            PG8_LDA(At, 0, 1); PG8_STAGE(PG8_SA(0, 0), a2, voffA);
            PG8_BAR; PG8_WAIT_L(0); PG8_MMA(1, 0, At, B0); PG8_BAR; PG8_SCHED;
            PG8_STAGE(PG8_SB(0, 1), b2 + hstep, voffB);
            PG8_WAIT_V(6); PG8_BAR; PG8_MMA(1, 1, At, B1); PG8_BAR;
            PG8_LDB(B0, 1, 0); PG8_SCHED; PG8_LDA(At, 1, 0); PG8_STAGE(PG8_SA(0, 1), a2 + hstep, voffA);
            PG8_WAIT_L(8); PG8_BAR; PG8_WAIT_L(0); PG8_MMA(0, 0, At, B0); PG8_BAR; PG8_SCHED;
            PG8_LDB(B1, 1, 1); PG8_STAGE(PG8_SB(1, 0), b3, voffB);
            PG8_BAR; PG8_WAIT_L(0); PG8_MMA(0, 1, At, B1); PG8_BAR;
            PG8_LDA(At, 1, 1); PG8_STAGE(PG8_SA(1, 0), a3, voffA);
            PG8_BAR; PG8_WAIT_L(0); PG8_MMA(1, 0, At, B0); PG8_BAR; PG8_SCHED;
            PG8_STAGE(PG8_SB(1, 1), b3 + hstep, voffB);
            PG8_WAIT_V(6); PG8_BAR; PG8_MMA(1, 1, At, B1); PG8_BAR;
            }
        }
        if constexpr (ALIGN_EPI) { if (wr == 0) PG8_BAR; }
        if constexpr (!Epi::AFTER_DRAIN) { E(acc, cur, wr, wc, fr, fq); S.done(cur); }
        if (!has_next) break;
#pragma unroll
        for (int a = 0; a < 2; ++a)
#pragma unroll
            for (int b = 0; b < 2; ++b)
#pragma unroll
                for (int m = 0; m < 4; ++m)
#pragma unroll
                    for (int n = 0; n < 2; ++n) acc[a][b][m][n] = (f32x4){0.f, 0.f, 0.f, 0.f};
        cur = nxt; cA = nA; cB = nB; ++ui;
        if constexpr (ALIGN_EPI) { if (wr == 1) PG8_BAR; }
    }
    PG8_WAIT_V(0);
    if constexpr (!ALIGN_EPI) { if (wr == 0) PG8_BAR; }
    PG8_BAR;
    if constexpr (Epi::AFTER_DRAIN) { E.fused(acc, cur, wr, wc, fr, fq, lds, wid, lane); S.done(cur); }
#undef PG8_SA
#undef PG8_SB
#undef PG8_STAGE
#undef PG8_LDA
#undef PG8_LDB
#undef PG8_MMA
#undef PG8_WAIT_V
#undef PG8_WAIT_L
#undef PG8_BAR
#undef PG8_SCHED
}
}
namespace swa {
constexpr int D = 128;
constexpr float THR = 8.f;
constexpr float SCALE = 0.08838834764831845f;
constexpr int NW = 8, QBLK = 32, KVBLK = 64, QB = NW * QBLK;
constexpr int SHM_V = KVBLK * D * 2, SHM_K = KVBLK * D * 2;
constexpr int NVS = 3;
constexpr int OFF_WS = NVS * SHM_V + 2 * SHM_K;
constexpr int OFF_CS = OFF_WS + NW * 64 * 4;
constexpr int OFF_SC = OFF_CS + 4096 * 8;
constexpr int LDS_BYTES = OFF_SC + 64;
constexpr int TABN = 320, TABOFF = 96;
#ifndef PIPE2
#define PIPE2 0
#endif

using bf16 = __hip_bfloat16;
typedef short bf16x8 __attribute__((ext_vector_type(8)));
typedef short s16x4 __attribute__((ext_vector_type(4)));
typedef float f32x16 __attribute__((ext_vector_type(16)));
typedef float f32x4 __attribute__((ext_vector_type(4)));
typedef unsigned u32x4 __attribute__((ext_vector_type(4)));
typedef unsigned u32x2 __attribute__((ext_vector_type(2)));

#define KSWZ(row, colB) ((row) * 256 + ((colB) ^ (((row) & 7) << 4)))
#define SBAR() __builtin_amdgcn_sched_barrier(0)
__device__ __forceinline__ int v_st(int k, int c) { const int kk = (k & ~0xC) | ((k & 4) << 1) | ((k & 8) >> 1); return ((kk >> 3) * 4 + (c >> 5)) * 512 + ((kk & 7) * 32 + (c & 31)) * 2; }
__device__ __forceinline__ int v_rd_base(int lane) { return ((lane & 3) << 3) | (((lane >> 2) & 3) << 6) | (((lane >> 4) & 1) << 5) | (((lane >> 5) & 1) << 8); }
constexpr int v_rd_off(int d0, int ks, int half) { return d0 * 512 + ks * 4096 + half * 2048; }
__device__ __forceinline__ int crow(int r, int hi) { return (r & 3) + 8 * (r >> 2) + 4 * hi; }
__device__ __forceinline__ unsigned cvtpk(float lo, float hi) { unsigned r; asm volatile("v_cvt_pk_bf16_f32 %0, %1, %2" : "=v"(r) : "v"(lo), "v"(hi)); return r; }
__device__ __forceinline__ bf16x8 load8(const bf16* p) { return *reinterpret_cast<const bf16x8*>(p); }

__device__ __forceinline__ void mask_tile(f32x16& p0, f32x16& p1, int dq, unsigned W) {
    const float NEG = -__builtin_inff();
#pragma unroll
    for (int r = 0; r < 16; ++r) {
        const int c = (r & 3) + 8 * (r >> 2);
        if ((unsigned)(dq - c) >= W) p0[r] = NEG;
        if ((unsigned)(dq - c - 32) >= W) p1[r] = NEG;
    }
}
__device__ __forceinline__ void bias_mask_tile(f32x16& p0, f32x16& p1, int dq, unsigned W, const float* tab) {
    const float NEG = -__builtin_inff();
    const float* tb = tab + TABOFF + dq;
#pragma unroll
    for (int q = 0; q < 4; ++q) {
#pragma unroll
        for (int e = 0; e < 4; ++e) { const int r = 4 * q + e, c = e + 8 * q;
            const float b0 = tb[-c], b1 = tb[-c - 32];
            p0[r] = ((unsigned)(dq - c) >= W) ? NEG : p0[r] + b0;
            p1[r] = ((unsigned)(dq - c - 32) >= W) ? NEG : p1[r] + b1; }
        asm volatile("" ::: "memory");
    }
}
__device__ __forceinline__ void partialSM(f32x16& p0, f32x16& p1, float& m_reg, float& mn, float& alpha) {
    float pmax = p0[0]; for (int r = 1; r < 16; ++r) pmax = fmaxf(pmax, p0[r]); for (int r = 0; r < 16; ++r) pmax = fmaxf(pmax, p1[r]);
    { auto rr = __builtin_amdgcn_permlane32_swap(__float_as_uint(pmax), __float_as_uint(pmax), false, false);
      pmax = fmaxf(__uint_as_float(rr[0]), __uint_as_float(rr[1])); }
    constexpr float C2 = 1.4426950408889634f * SCALE;
    if (__builtin_expect(__all((pmax - m_reg) * SCALE <= THR), 1)) { mn = m_reg; alpha = 1.f; }
    else { mn = fmaxf(m_reg, pmax); alpha = __builtin_amdgcn_exp2f((m_reg - mn) * C2); m_reg = mn; }
    const float mnL = -mn * C2;
    for (int r = 0; r < 16; ++r) p0[r] = fmaf(p0[r], C2, mnL); for (int r = 0; r < 16; ++r) p1[r] = fmaf(p1[r], C2, mnL);
    for (int r = 0; r < 16; ++r) p0[r] = __builtin_amdgcn_exp2f(p0[r]);
}
__device__ __forceinline__ void finishSM(f32x16& p0, f32x16& p1, float alpha, float& l_reg, bf16x8& pa0, bf16x8& pa1, bf16x8& pa2, bf16x8& pa3) {
    for (int r = 0; r < 16; ++r) p1[r] = __builtin_amdgcn_exp2f(p1[r]);
    float ps = 0; for (int r = 0; r < 16; ++r) ps += p0[r]; for (int r = 0; r < 16; ++r) ps += p1[r];
    { auto rr = __builtin_amdgcn_permlane32_swap(__float_as_uint(ps), __float_as_uint(ps), false, false);
      ps = __uint_as_float(rr[0]) + __uint_as_float(rr[1]); }
    l_reg = l_reg * alpha + ps;
#define PK4(P, B_, OUT) do { unsigned a0 = cvtpk(P[B_+0], P[B_+1]), a1 = cvtpk(P[B_+2], P[B_+3]);                          \
        unsigned b0 = cvtpk(P[B_+4], P[B_+5]), b1 = cvtpk(P[B_+6], P[B_+7]);                                             \
        auto r0 = __builtin_amdgcn_permlane32_swap(a0, b0, false, false); auto r1 = __builtin_amdgcn_permlane32_swap(a1, b1, false, false); \
        u32x4 w = {r0[0], r1[0], r0[1], r1[1]}; OUT = *reinterpret_cast<bf16x8*>(&w); } while (0)
    PK4(p0, 0, pa0); PK4(p0, 8, pa1); PK4(p1, 0, pa2); PK4(p1, 8, pa3);
#undef PK4
}
#define KRD(dst, base, off) asm volatile("ds_read_b128 %0, %1 offset:%2" : "=&v"(dst) : "v"(base), "i"(off) : "memory")
#define SB_ALU() __builtin_amdgcn_sched_barrier(0)
template <int KB, bool SK, int MODE>
__device__ __forceinline__ void qkt(f32x16& p0, f32x16& p1, const int* kba, int r32, int hi, const bf16x8* qr, bool act, const unsigned long long* csk, const unsigned long long* csq) {
    if (SK && !act) { const float NEG = -__builtin_inff();
#pragma unroll
        for (int r = 0; r < 16; ++r) { p0[r] = NEG; p1[r] = NEG; } return; }
    constexpr int OB = KB * SHM_K;
    bf16x8 a0, a1, b0, b1;
    KRD(a0, kba[0], OB); KRD(a1, kba[0], OB + 8192); KRD(b0, kba[1], OB); KRD(b1, kba[1], OB + 8192);
    p0 = f32x16{}; p1 = f32x16{};
    if constexpr (MODE == 1) {
        const u32x2 t0 = *(const u32x2*)(csk), t1 = *(const u32x2*)(csk + 32), tq = *(const u32x2*)(csq);
        const u32x4 qv = {0x3f803f80u, 0x00003f80u, tq.x ^ 0x80008000u, tq.y ^ 0x00008000u};
        const bf16x8 qx = hi ? bf16x8{} : __builtin_bit_cast(bf16x8, qv);
        const u32x4 k0 = {t0.x, t0.y, 0x3f803f80u, 0x00003f80u}, k1 = {t1.x, t1.y, 0x3f803f80u, 0x00003f80u};
        p0 = __builtin_amdgcn_mfma_f32_32x32x16_bf16(__builtin_bit_cast(bf16x8, k0), qx, p0, 0, 0, 0);
        p1 = __builtin_amdgcn_mfma_f32_32x32x16_bf16(__builtin_bit_cast(bf16x8, k1), qx, p1, 0, 0, 0);
    }
#define QK_STEP(X0, X1, d0, NB, LD0) do { asm volatile("s_waitcnt lgkmcnt(%0)" :: "i"(NB) : "memory"); SB_ALU(); \
        p0 = __builtin_amdgcn_mfma_f32_32x32x16_bf16(X0, qr[d0], p0, 0, 0, 0); p1 = __builtin_amdgcn_mfma_f32_32x32x16_bf16(X1, qr[d0], p1, 0, 0, 0); SB_ALU(); \
        if (LD0 < 8) { KRD(X0, kba[(LD0) & 3], OB + ((LD0) >> 2) * 128); KRD(X1, kba[(LD0) & 3], OB + ((LD0) >> 2) * 128 + 8192); } } while (0)
    __builtin_amdgcn_s_setprio(1);
    QK_STEP(a0, a1, 0, 2, 2); QK_STEP(b0, b1, 1, 2, 3); QK_STEP(a0, a1, 2, 2, 4); QK_STEP(b0, b1, 3, 2, 5);
    QK_STEP(a0, a1, 4, 2, 6); QK_STEP(b0, b1, 5, 2, 7); QK_STEP(a0, a1, 6, 2, 8); QK_STEP(b0, b1, 7, 0, 9);
    __builtin_amdgcn_s_setprio(0);
#undef QK_STEP
}
template <int VB, bool SK>
__device__ __forceinline__ void pv_tile(f32x16* o, int vb0, bf16x8 pa0, bf16x8 pa1, bf16x8 pa2, bf16x8 pa3, bool act) {
    if (SK && !act) return;
#define TRRD(dst, off) asm volatile("ds_read_b64_tr_b16 %0, %1 offset:%2" : "=&v"(dst) : "v"(vb0), "i"(off) : "memory")
#define PV_D0(d0) do { s16x4 l0, l1, l2, l3, h0, h1, h2, h3; constexpr int b_ = VB * SHM_V + v_rd_off(d0, 0, 0); \
        TRRD(l0, b_); TRRD(h0, b_ + 2048); TRRD(l1, b_ + 4096); TRRD(h1, b_ + 6144); TRRD(l2, b_ + 8192); TRRD(h2, b_ + 10240); TRRD(l3, b_ + 12288); TRRD(h3, b_ + 14336); \
        asm volatile("s_waitcnt lgkmcnt(0)" ::: "memory"); SBAR();   \
        o[d0] = __builtin_amdgcn_mfma_f32_32x32x16_bf16(pa0, (bf16x8){l0[0], l0[1], l0[2], l0[3], h0[0], h0[1], h0[2], h0[3]}, o[d0], 0, 0, 0);   \
        o[d0] = __builtin_amdgcn_mfma_f32_32x32x16_bf16(pa1, (bf16x8){l1[0], l1[1], l1[2], l1[3], h1[0], h1[1], h1[2], h1[3]}, o[d0], 0, 0, 0);   \
        o[d0] = __builtin_amdgcn_mfma_f32_32x32x16_bf16(pa2, (bf16x8){l2[0], l2[1], l2[2], l2[3], h2[0], h2[1], h2[2], h2[3]}, o[d0], 0, 0, 0);   \
        o[d0] = __builtin_amdgcn_mfma_f32_32x32x16_bf16(pa3, (bf16x8){l3[0], l3[1], l3[2], l3[3], h3[0], h3[1], h3[2], h3[3]}, o[d0], 0, 0, 0); } while (0)
    __builtin_amdgcn_s_setprio(1); PV_D0(0); PV_D0(1); PV_D0(2); PV_D0(3); __builtin_amdgcn_s_setprio(0);
#undef PV_D0
#undef TRRD
}

struct BlockRef { const bf16* Q; const bf16* K; const bf16* V; bf16* O; float* L; const float* aux; int P0, skv, W, pad; };
__device__ __forceinline__ int swa_jlo(int P0, int W) { const int lowk = P0 - W + 1; return lowk > 0 ? lowk / KVBLK : 0; }
#define ROW(p, k0, rr0, rs_) ((const bf16*)((const char*)(p) + (size_t)((k0) + (rr0)) * (size_t)(rs_) * 2 + voff))
#define VMW() asm volatile("s_waitcnt vmcnt(0)" ::: "memory")
#define SLOAD_H(Kp, Vp, k0, rs_) do { st_v0 = load8(ROW(Vp, k0, 0, rs_)); st_v1 = load8(ROW(Vp, k0, 32, rs_));              \
                         st_k0 = load8(ROW(Kp, k0, 0, rs_)); st_k1 = load8(ROW(Kp, k0, 32, rs_)); } while (0)
#define SWRITE_HK(bf) do { *(bf16x8*)(K_lds + (bf) * SHM_K + kws) = st_k0; *(bf16x8*)(K_lds + (bf) * SHM_K + kws + 32 * 256) = st_k1; } while (0)
#define SWRITE_HV(off_) do { *(bf16x8*)(V_lds + (off_) + vst0) = st_v0; *(bf16x8*)(V_lds + (off_) + vst1) = st_v1; } while (0)
template <int MODE, bool SK, int RS>
__device__ __forceinline__ void swa_block(const BlockRef& cur, char* lds, const int wave_u) {
    int tid = wave_u * 64 + fresh_lane(); asm volatile("" : "+v"(tid));
    const int wid = __builtin_amdgcn_readfirstlane(tid >> 6), lane = tid & 63, r32 = lane & 31, hi = lane >> 5;
    const int W = cur.W, skv = cur.skv; constexpr int rs = RS;
    const int j_lo = swa_jlo(cur.P0, W);
    int j_hi = (cur.P0 + QB - 1) / KVBLK + 1; if (j_hi > skv / KVBLK) j_hi = skv / KVBLK;
    const int NT = j_hi - j_lo;
    const int qlo = cur.P0 + wid * QBLK, qm = qlo + r32 - 4 * hi;
    char* V_lds = lds; char* K_lds = lds + NVS * SHM_V;
    float* ws = (float*)(lds + OFF_WS) + wid * 64; float* li_l = ws, * al_l = ws + 32;
    const int sr = tid >> 4, sc = (tid & 15) * 8, vst0 = v_st(sr, sc), vst1 = v_st(32 + sr, sc), kws = KSWZ(sr, sc * 2);
    const unsigned voff = (unsigned)(sr * RS + sc) * 2u, qoff = (unsigned)(r32 * RS + hi * 8) * 2u;
    const int vb0 = (int)(uintptr_t)V_lds + v_rd_base(lane);
    int kba[4];
#pragma unroll
    for (int dd = 0; dd < 4; ++dd) kba[dd] = (int)(uintptr_t)K_lds + KSWZ(r32, (dd * 16 + hi * 8) * 2);
    const bf16* Kh = cur.K; const bf16* Vh = cur.V;
    bf16x8 qr[8], st_v0, st_v1, st_k0, st_k1;
#define KBASE(t) ((j_lo + (t)) * KVBLK)
    { const char* qb_ = (const char*)(cur.Q + (size_t)(cur.P0 + wid * QBLK) * RS);
#pragma unroll
      for (int d0 = 0; d0 < 8; ++d0) qr[d0] = load8((const bf16*)(qb_ + qoff + d0 * 32)); }
    SLOAD_H(Kh, Vh, KBASE(0), RS);
    unsigned long long* cs = (unsigned long long*)(lds + OFF_CS);
    if constexpr (MODE == 1) {
        float* sc8 = (float*)(lds + OFF_SC);
        const int n = cur.P0 + QB; const float* lf = cur.aux;
        f32x4 a = {0.f, 0.f, 0.f, 0.f}, b = {0.f, 0.f, 0.f, 0.f};
        if (8 * tid < n) { a = *(const f32x4*)(lf + 8 * tid); b = *(const f32x4*)(lf + 8 * tid + 4); }
        a[1] += a[0]; a[2] += a[1]; a[3] += a[2]; b[0] += a[3]; b[1] += b[0]; b[2] += b[1]; b[3] += b[2];
        const float tot = b[3]; float inc = tot;
#pragma unroll
        for (int o_ = 1; o_ < 64; o_ <<= 1) { const float v = __builtin_bit_cast(float, __builtin_amdgcn_ds_bpermute((lane - o_) << 2, __builtin_bit_cast(int, inc))); if (lane >= o_) inc += v; }
        if (lane == 63) sc8[wid] = inc;
        __syncthreads();
        float base = inc - tot;
        for (int w = 0; w < wid; ++w) base += sc8[w];
        const float ninv = -1.f / SCALE;
        if (8 * tid < n) {
#pragma unroll
            for (int e = 0; e < 8; ++e) { const float v = ((e < 4 ? a[e & 3] : b[e & 3]) + base) * ninv;
                const unsigned h = cvtpk(v, 0.f) & 0xffffu; const float r1 = v - __uint_as_float(h << 16);
                const unsigned m = cvtpk(r1, 0.f) & 0xffffu; const float r2 = r1 - __uint_as_float(m << 16);
                const unsigned lo = cvtpk(r2, 0.f) & 0xffffu;
                cs[8 * tid + e] = (unsigned long long)(h | (m << 16)) | ((unsigned long long)lo << 32); }
        }
        __syncthreads();
    }
    if constexpr (MODE == 2) { if (tid < TABN) ((float*)cs)[tid] = cur.aux[tid]; }
    VMW(); SWRITE_HV(0); SWRITE_HK(0);
    __syncthreads();
    float m_reg = -1e30f, l_reg = 0; f32x16 o[4] = {};
#define RESC(a) do { if (__any((a) < 1.f)) { if (hi == 0) al_l[r32] = (a); asm volatile("s_waitcnt lgkmcnt(0)" ::: "memory");              \
                     for (int d_ = 0; d_ < 4; ++d_) for (int r = 0; r < 16; ++r) o[d_][r] *= al_l[crow(r, hi)]; } } while (0)
#define ACT(t) (KBASE(t) <= qlo + QBLK - 1 && KBASE(t) + KVBLK - 1 >= qlo - W + 1)
#define MASKT(P0_, P1_, t) do { const int kb_ = KBASE(t); \
        if constexpr (MODE == 2) { bias_mask_tile(P0_, P1_, qm - kb_, (unsigned)W, (const float*)cs); } \
        else { if (kb_ + KVBLK - 1 > qlo || kb_ <= qlo + QBLK - 1 - W) mask_tile(P0_, P1_, qm - kb_, (unsigned)W); } } while (0)
#define CSK(t) (cs + KBASE(t) + r32)
    const unsigned long long* const qx = cs + cur.P0 + wid * QBLK + r32;
    if constexpr (MODE == 1 || PIPE2) {
    int vs_prev = 0, vs_cur = 0, vs_next = SHM_V;
#define ROTV() do { vs_prev = vs_cur; vs_cur = vs_next; vs_next = (vs_next == (NVS - 1) * SHM_V) ? 0 : vs_next + SHM_V; } while (0)
#define STAGE_BAR(t, BUF) do { \
        if ((t) + 1 < NT) { VMW(); SWRITE_HK((BUF) ^ 1); SWRITE_HV(vs_next); } \
        asm volatile("s_waitcnt vmcnt(0) lgkmcnt(0)\n\ts_barrier" ::: "memory"); \
        if ((t) + 2 < NT) { SLOAD_H(Kh, Vh, KBASE((t) + 2), RS); } SBAR(); ROTV(); } while (0)
    f32x16 pA0, pA1, pB0, pB1; float mnA, mnB, alA, alB; bf16x8 pa0, pa1, pa2, pa3;
    if (NT > 1) { SLOAD_H(Kh, Vh, KBASE(1), RS); } SBAR();
    qkt<0, SK, MODE>(pA0, pA1, kba, r32, hi, qr, ACT(0), CSK(0), qx);
    if (!SK || ACT(0)) MASKT(pA0, pA1, 0);
    partialSM(pA0, pA1, m_reg, mnA, alA);
    STAGE_BAR(0, 0);
#define HALF_STEP(PX0, PX1, mnX, alX, PY0, PY1, alY, t, KB) do { \
        SBAR(); qkt<KB, SK, MODE>(PX0, PX1, kba, r32, hi, qr, ACT(t), CSK(t), qx); \
        finishSM(PY0, PY1, alY, l_reg, pa0, pa1, pa2, pa3); SBAR(); \
        pv_tile<0, SK>(o, vb0 + vs_prev, pa0, pa1, pa2, pa3, ACT((t) - 1)); \
        if (!SK || ACT(t)) MASKT(PX0, PX1, (t)); partialSM(PX0, PX1, m_reg, mnX, alX); \
        RESC(alX); \
        STAGE_BAR(t, KB); } while (0)
    for (int t = 1; t + 1 < NT; t += 2) {
        HALF_STEP(pB0, pB1, mnB, alB, pA0, pA1, alA, t, 1);
        HALF_STEP(pA0, pA1, mnA, alA, pB0, pB1, alB, t + 1, 0);
    }
    HALF_STEP(pB0, pB1, mnB, alB, pA0, pA1, alA, NT - 1, 1);
    finishSM(pB0, pB1, alB, l_reg, pa0, pa1, pa2, pa3); SBAR();
    pv_tile<0, SK>(o, vb0 + vs_prev, pa0, pa1, pa2, pa3, ACT(NT - 1));
#undef HALF_STEP
#undef STAGE_BAR
#undef ROTV
    } else {
    const bool grpB = wid >= 4;
    int vs_cur = 0, vs_next = SHM_V;
    bf16x8 u_v0, u_v1, u_k0, u_k1;
#define SLOAD_U(Kp, Vp, k0, rs_) do { u_v0 = load8(ROW(Vp, k0, 0, rs_)); u_v1 = load8(ROW(Vp, k0, 32, rs_)); u_k0 = load8(ROW(Kp, k0, 0, rs_)); u_k1 = load8(ROW(Kp, k0, 32, rs_)); } while (0)
#define SWRITE_U(bf, off_) do { *(bf16x8*)(K_lds + (bf) * SHM_K + kws) = u_k0; *(bf16x8*)(K_lds + (bf) * SHM_K + kws + 32 * 256) = u_k1; \
        *(bf16x8*)(V_lds + (off_) + vst0) = u_v0; *(bf16x8*)(V_lds + (off_) + vst1) = u_v1; } while (0)
#define STAGE_BAR(t, BUF) do { \
        if ((t) + 1 < NT) { if ((t) + 2 < NT) asm volatile("s_waitcnt vmcnt(4)" ::: "memory"); else asm volatile("s_waitcnt vmcnt(0)" ::: "memory"); \
            if ((BUF) == 0) { SWRITE_U(1, vs_next); } else { SWRITE_HK(0); SWRITE_HV(vs_next); } } \
        asm volatile("s_waitcnt lgkmcnt(0)\n\ts_barrier" ::: "memory"); \
        if ((t) + 3 < NT) { if ((BUF) == 0) { SLOAD_U(Kh, Vh, KBASE((t) + 3), RS); } else { SLOAD_H(Kh, Vh, KBASE((t) + 3), RS); } } SBAR(); } while (0)
#define TILE(t, BUF) do { \
        const bool act_ = !SK || ACT(t); bf16x8 pa0, pa1, pa2, pa3; \
        if (act_) { f32x16 p0, p1; float mn, al; \
            qkt<BUF, false, MODE>(p0, p1, kba, r32, hi, qr, true, CSK(t), qx); \
            MASKT(p0, p1, t); partialSM(p0, p1, m_reg, mn, al); RESC(al); \
            finishSM(p0, p1, al, l_reg, pa0, pa1, pa2, pa3); SBAR(); } \
        if (grpB) STAGE_BAR(t, BUF); \
        if (act_) { pv_tile<0, false>(o, vb0 + vs_cur, pa0, pa1, pa2, pa3, true); SBAR(); } \
        if (!grpB) STAGE_BAR(t, BUF); \
        vs_cur = vs_next; vs_next = (vs_next == (NVS - 1) * SHM_V) ? 0 : vs_next + SHM_V; } while (0)
    if (NT > 1) { SLOAD_U(Kh, Vh, KBASE(1), RS); } SBAR();
    if (NT > 2) { SLOAD_H(Kh, Vh, KBASE(2), RS); } SBAR();
    for (int t = 0; t < NT; t += 2) { TILE(t, 0); TILE(t + 1, 1); }
#undef SLOAD_U
#undef SWRITE_U
#undef STAGE_BAR
    }
    {
        int tid2 = wave_u * 64 + fresh_lane(); asm volatile("" : "+v"(tid2));
        const int r32e = tid2 & 31, hie = (tid2 >> 5) & 1;
        if (hie == 0) li_l[r32e] = l_reg; asm volatile("s_waitcnt lgkmcnt(0)" ::: "memory");
        float rli[16];
#pragma unroll
        for (int r = 0; r < 16; ++r) rli[r] = __builtin_amdgcn_rcpf(li_l[crow(r, hie)]);
        char* stg = lds + (wid < 4 ? NVS * SHM_V + wid * 8192 : OFF_CS + (wid - 4) * 8192);
        { unsigned short* sw = (unsigned short*)(stg + hie * 1024 + r32e * 2);
#pragma unroll
          for (int r = 0; r < 16; ++r)
#pragma unroll
              for (int d0 = 0; d0 < 4; ++d0) sw[((r & 3) + 8 * (r >> 2)) * 128 + d0 * 32] = (unsigned short)cvtpk(o[d0][r] * rli[r], 0.f); }
        asm volatile("s_waitcnt lgkmcnt(0)" ::: "memory");
        { const int ln = tid2 & 63; char* Ow = (char*)(cur.O + (size_t)(cur.P0 + wid * QBLK + (ln >> 4)) * rs) + (ln & 15) * 16;
#pragma unroll
          for (int i = 0; i < 8; ++i) { const u32x4 v = *(const u32x4*)(stg + i * 1024 + ln * 16); *(u32x4*)(Ow + (size_t)(4 * i) * rs * 2) = v; } }
        if constexpr (MODE == 2) { if (hie == 0) cur.L[(size_t)(cur.P0 + wid * QBLK + r32e) * (RS / 128)] = m_reg * SCALE + __logf(l_reg); }
    }
    __syncthreads();
#undef RESC
#undef KBASE
#undef ACT
#undef MASKT
#undef CSK
#undef TILE
}
#undef ROW
#undef VMW
#undef SLOAD_H
#undef SWRITE_HK
#undef SWRITE_HV
#undef SWRITE_H
#undef KSWZ
#undef KRD
#undef SB_ALU
#undef SBAR
}
namespace cg = cooperative_groups;
constexpr int NWAVES = 8;
constexpr int BATCH = 4, SEQ = 4096, DM = 2048, DEPTH = 2, NHF = 8, HD = 128, DH = 1024, NIN = 6152, DFF = 8192;
constexpr int M = BATCH * SEQ;
constexpr int NQKV = 6 * DH;
constexpr float NORM_EPS = 1e-6f;
constexpr size_t MiB = 1u << 20;
constexpr size_t WS_LF = 1 * MiB;
constexpr size_t WS_BT = 1 * MiB + 768 * 1024;
constexpr size_t WS_LSE = 2 * MiB;
constexpr size_t WS_WIN = 4 * MiB, WS_WOUT = 28 * MiB, WS_W1 = 36 * MiB, WS_W2 = 68 * MiB;
constexpr size_t WS_XN = 100 * MiB;
constexpr size_t WS_QKV = 164 * MiB;
constexpr size_t WS_OP = 356 * MiB;
constexpr size_t WS_YA = 452 * MiB;
constexpr size_t WS_H = 164 * MiB;
constexpr size_t WS_D1 = 420 * MiB;
constexpr size_t WS_END = 484 * MiB;
constexpr int LDS_BYTES = 147456;

#define GAS __attribute__((address_space(1)))
#define LAS __attribute__((address_space(3)))
typedef unsigned short bf16r;
typedef unsigned v4u __attribute__((ext_vector_type(4)));
typedef unsigned v2u __attribute__((ext_vector_type(2)));
typedef float f32x4 __attribute__((ext_vector_type(4)));
#define LDS_WAIT() asm volatile("s_waitcnt lgkmcnt(0)" ::: "memory")
__device__ __forceinline__ unsigned f2bf(float f) { unsigned u = __builtin_bit_cast(unsigned, f); return (u + 0x7fffu + ((u >> 16) & 1u)) >> 16; }
__device__ __forceinline__ unsigned pk2(float lo, float hi) { return f2bf(lo) | (f2bf(hi) << 16); }
__device__ __forceinline__ float bf2f(unsigned short h) { return __builtin_bit_cast(float, (unsigned)h << 16); }
__device__ __forceinline__ float wave_sum(float v, int lane) {
#pragma unroll
    for (int o = 1; o < 64; o <<= 1) v += __builtin_bit_cast(float, __builtin_amdgcn_ds_bpermute((lane ^ o) << 2, __builtin_bit_cast(int, v)));
    return v;
}

#define XB_TMO      128
#define XB_XCNT(j)  (256  + 64 * (j))
#define XB_XSUB(j)  (1280 + 64 * (j))
#define XB_XGEN(j)  (2304 + 64 * (j))
#define XB_TOP      3328
#define XB_TOPGEN   3392
#define XCD_BAR_WORDS 3456
#define XB_SPIN_CAP (1u << 18)

__device__ __forceinline__ unsigned xb_ld(unsigned* p)              { return __hip_atomic_load(p, __ATOMIC_RELAXED, __HIP_MEMORY_SCOPE_AGENT); }
__device__ __forceinline__ unsigned xb_add(unsigned* p, unsigned v) { return __hip_atomic_fetch_add(p, v, __ATOMIC_RELAXED, __HIP_MEMORY_SCOPE_AGENT); }
__device__ __forceinline__ unsigned xb_xcc_id() { return (unsigned)__builtin_amdgcn_s_getreg((3 << 11) | 20) & 0xFu; }
#define XB_SPIN(cond, bar) do { unsigned _sp = 0; while (cond) { __builtin_amdgcn_s_sleep(1); \
    if ((++_sp & 255u) == 0u) { if (xb_ld(&(bar)[XB_TMO])) break; if (_sp > XB_SPIN_CAP) { atomicAdd(&(bar)[XB_TMO], 1u); break; } } } } while (0)

struct XcdBarrier {
    unsigned* bar; unsigned x;
    volatile LAS unsigned* st;
};

__device__ __forceinline__ XcdBarrier xcd_barrier_post(unsigned* bar, volatile LAS unsigned* st) {
    XcdBarrier b; b.bar = bar; b.x = xb_xcc_id(); b.st = st;
    if (threadIdx.x == 0) (void)xb_add(&bar[XB_XCNT(b.x)], 1u);
    return b;
}
__device__ __forceinline__ void xcd_barrier_complete(unsigned* bar, unsigned x, unsigned& nloc, unsigned& nx) {
    const unsigned G = gridDim.x * gridDim.y * gridDim.z;
    unsigned sum, cnt, mine, sp = 0u;
    for (;;) {
        sum = 0u; cnt = 0u; mine = 0u;
#pragma unroll
        for (unsigned j = 0; j < 16; ++j) { const unsigned c = xb_ld(&bar[XB_XCNT(j)]); sum += c; cnt += (c > 0u) ? 1u : 0u; mine = (j == x) ? c : mine; }
        if (sum == G) break;
        __builtin_amdgcn_s_sleep(1);
        if ((++sp & 255u) == 0u) { if (xb_ld(&bar[XB_TMO])) break; if (sp > XB_SPIN_CAP) { atomicAdd(&bar[XB_TMO], 1u); break; } }
    }
    nloc = mine > 0u ? mine : 1u; nx = cnt > 0u ? cnt : 1u;
}

__device__ __forceinline__ void xcd_barrier(const XcdBarrier& b, const bool leader  ) {
    asm volatile("s_waitcnt vmcnt(0)" ::: "memory");
    __syncthreads();
    if (leader) {
        unsigned* bar = b.bar;
        __builtin_amdgcn_s_waitcnt(0);
        unsigned nloc = b.st[0], nx = b.st[1];
        if (nloc == 0u) { xcd_barrier_complete(bar, b.x, nloc, nx); b.st[0] = nloc; b.st[1] = nx; }
        const unsigned old = xb_add(&bar[XB_XSUB(b.x)], 1u);
        const unsigned gen = old / nloc;
        if (old + 1u == (gen + 1u) * nloc) {
            __builtin_amdgcn_fence(__ATOMIC_RELEASE, "agent");
            asm volatile("s_waitcnt vmcnt(0)" ::: "memory");
            const unsigned og = xb_add(&bar[XB_TOP], 1u);
            const unsigned tg = og / nx;
            if (og + 1u == (tg + 1u) * nx) xb_add(&bar[XB_TOPGEN], 1u);
            else XB_SPIN(xb_ld(&bar[XB_TOPGEN]) == tg, bar);
            __builtin_amdgcn_fence(__ATOMIC_ACQUIRE, "agent");
            xb_add(&bar[XB_XGEN(b.x)], 1u);
            asm volatile("s_waitcnt vmcnt(0)" ::: "memory");
        } else {
            XB_SPIN(xb_ld(&bar[XB_XGEN(b.x)]) == gen, bar);
            __builtin_amdgcn_fence(__ATOMIC_ACQUIRE, "agent");
            asm volatile("s_waitcnt vmcnt(0)" ::: "memory");
        }
    }
    __syncthreads();
}

__device__ __forceinline__ f32x4 add_bf4(f32x4 v, v2u d) {
    v.x += __builtin_bit_cast(float, d.x << 16); v.y += __builtin_bit_cast(float, d.x & 0xffff0000u);
    v.z += __builtin_bit_cast(float, d.y << 16); v.w += __builtin_bit_cast(float, d.y & 0xffff0000u); return v; }
struct Args { const float* in[12]; float* out; unsigned char* ws; };

__device__ __forceinline__ void transpose_item(const float* W, int K, int ldw, int c0, int N, bf16r* WT, int row_off, LAS float* scr, int item, int lane) {
    const int nblk = N / 32, kb = item / nblk, nb = item % nblk, k0 = 64 * kb, n0 = 32 * nb;
#pragma unroll 8
    for (int i = 0; i < 32; ++i) { const int kk = 2 * i + (lane >> 5); scr[kk * 33 + (lane & 31)] = W[(size_t)(k0 + kk) * ldw + c0 + n0 + (lane & 31)]; }
    LDS_WAIT(); asm volatile("" ::: "memory");
    const int c = lane & 7;
#pragma unroll
    for (int j = 0; j < 4; ++j) { const int n = (lane >> 3) + 8 * j; const LAS float* s = scr + (8 * c) * 33 + n;
        v4u o; o.x = pk2(s[0 * 33], s[1 * 33]); o.y = pk2(s[2 * 33], s[3 * 33]); o.z = pk2(s[4 * 33], s[5 * 33]); o.w = pk2(s[6 * 33], s[7 * 33]);
        *(v4u*)(WT + (size_t)(row_off + n0 + n) * K + k0 + 8 * c) = o; }
    LDS_WAIT(); asm volatile("" ::: "memory");
}

__device__ __forceinline__ int t5_bucket(int dist) {
    if (dist < 16) return dist;
    const int thr[15] = {22, 30, 40, 54, 73, 99, 134, 182, 246, 332, 450, 609, 825, 1117, 1513};
    int b = 16;
#pragma unroll
    for (int i = 0; i < 15; ++i) b += (dist >= thr[i]) ? 1 : 0;
    return b;
}

#ifndef GEMM_WGM
#define GEMM_WGM 4
#endif
#ifndef STAGGER_US
#define STAGGER_US 0
#endif
__device__ __forceinline__ void stagger_start(int bx) {
    const unsigned long long ticks = (unsigned long long)(((bx >> 3) & 3) * STAGGER_US * 100);
    const unsigned long long t0 = __builtin_amdgcn_s_memrealtime();
    while (__builtin_amdgcn_s_memrealtime() - t0 < ticks) __builtin_amdgcn_s_sleep(4);
}
#define PHASE_PTRS() \
    const __attribute__((address_space(4))) Args* ap_ = (const __attribute__((address_space(4))) Args*)__builtin_amdgcn_kernarg_segment_ptr(); asm volatile("" : "+s"(ap_)); \
    unsigned char* const ws = ap_->ws; (void)ws; \
    const float* const x_in = ap_->in[0]; const float* const norm1_g = ap_->in[1]; const float* const w_in = ap_->in[2]; const float* const forget_b = ap_->in[3]; \
    const float* const rel_bias = ap_->in[4]; const float* const ona_g = ap_->in[5]; const float* const onb_g = ap_->in[6]; const float* const w_out = ap_->in[7]; \
    const float* const norm2_g = ap_->in[8]; const float* const w_mlp_in = ap_->in[9]; const float* const w_mlp_out = ap_->in[10]; const float* const final_g = ap_->in[11]; \
    float* const XR = ap_->out; \
    float* const LF = (float*)(ws + WS_LF); float* const BT = (float*)(ws + WS_BT); float* const LSE = (float*)(ws + WS_LSE); \
    bf16r* const Win_t = (bf16r*)(ws + WS_WIN); bf16r* const Wout_t = (bf16r*)(ws + WS_WOUT); bf16r* const W1_t = (bf16r*)(ws + WS_W1); bf16r* const W2_t = (bf16r*)(ws + WS_W2); \
    bf16r* const XN = (bf16r*)(ws + WS_XN); bf16r* const QKV = (bf16r*)(ws + WS_QKV); bf16r* const OP = (bf16r*)(ws + WS_OP); bf16r* const YA = (bf16r*)(ws + WS_YA); \
    bf16r* const HB = (bf16r*)(ws + WS_H); bf16r* const D1 = (bf16r*)(ws + WS_D1); \
    (void)x_in; (void)norm1_g; (void)w_in; (void)forget_b; (void)rel_bias; (void)ona_g; (void)onb_g; (void)w_out; (void)norm2_g; (void)w_mlp_in; (void)w_mlp_out; (void)final_g; (void)XR; \
    (void)LF; (void)BT; (void)LSE; (void)Win_t; (void)Wout_t; (void)W1_t; (void)W2_t; (void)XN; (void)QKV; (void)OP; (void)YA; (void)HB; (void)D1
__global__ void __launch_bounds__(NWAVES * 64, 2) hymba_fwd(Args args) {
    extern __shared__ __attribute__((aligned(16))) unsigned char lds[];
    cg::grid_group grid = cg::this_grid();
    const int wave_u = __builtin_amdgcn_readfirstlane((int)threadIdx.x >> 6);
    volatile LAS unsigned* bst = (volatile LAS unsigned*)((LAS unsigned char*)lds + 131072);
    if (threadIdx.x < 2) bst[threadIdx.x] = 0u;
    __syncthreads();
    if (args.ws == nullptr) grid.sync();
    const XcdBarrier xbar = xcd_barrier_post((unsigned*)args.ws, bst);
    const int G = gridDim.x, bx = blockIdx.x;
    const int vcu = (G % 8 == 0) ? (bx % 8) * (G / 8) + bx / 8 : bx;
    const int NGW = G * NWAVES;
#ifdef DIAG
#define STAMP(k) do { if (blockIdx.x == 0 && threadIdx.x == 0) ((unsigned long long*)(args.ws + 512 * 1024))[(k)] = __builtin_amdgcn_s_memrealtime(); } while (0)
#else
#define STAMP(k) do {} while (0)
#endif
#define PHASE_IDS() int tid = wave_u * 64 + fresh_lane(); asm volatile("" : "+v"(tid)); const int lane = tid & 63, wave = wave_u, gw = vcu * NWAVES + wave; (void)lane; (void)gw
    constexpr size_t QSTR = (size_t)M * DH;

    { PHASE_IDS(); PHASE_PTRS();
    for (int i = gw * 64 + lane; i < 3 * 8 * swa::TABN; i += NGW * 64) {
        const int e = i % swa::TABN, h = (i / swa::TABN) % 8, p = i / (swa::TABN * 8), rel = e - swa::TABOFF, dil = (p == 0) ? 1 : (p == 1) ? 4 : 16;
        BT[i] = (rel >= 0 && rel <= 128) ? rel_bias[t5_bucket(rel * dil) * 8 + h] * (1.f / swa::SCALE) : 0.f;
    }
    }

    STAMP(0);
#pragma unroll 1
    for (int l = 0; l < DEPTH; ++l) {
#if PHASES & 1
        for (int rep_ = 0; rep_ < REP0; ++rep_) {
            PHASE_IDS(); PHASE_PTRS();
            LAS float* scr = (LAS float*)(lds) + wave * 4096;
            const float* Wi = w_in + (size_t)l * DM * NIN; const float* Wo = w_out + (size_t)l * DM * DM;
            const float* Wa = w_mlp_in + (size_t)l * DM * DFF; const float* Wb = w_mlp_out + (size_t)l * DFF * DM;
            constexpr int I_S = (DM / 64) * (DH / 32), I_O = (DM / 64) * (DM / 32), I_1 = (DM / 64) * (DFF / 32), I_2 = (DFF / 64) * (DM / 32);
            constexpr int NITEMS = 6 * I_S + I_O + I_1 + I_2;
            for (int it = gw; it < NITEMS; it += NGW) {
                int r = it;
                if (r < 6 * I_S) { const int s = r / I_S; const int c0 = s * DH + (s >= 3 ? 8 : 0); transpose_item(Wi, DM, NIN, c0, DH, Win_t, s * DH, scr, r % I_S, lane); continue; } r -= 6 * I_S;
                if (r < I_O) { transpose_item(Wo, DM, DM, 0, DM, Wout_t, 0, scr, r, lane); continue; } r -= I_O;
                if (r < I_1) { transpose_item(Wa, DM, DFF, 0, DFF, W1_t, 0, scr, r, lane); continue; } r -= I_1;
                transpose_item(Wb, DFF, DM, 0, DM, W2_t, 0, scr, r, lane);
            }
            __syncthreads();
            LAS f32x4* wf = (LAS f32x4*)lds;
            const float* g1 = norm1_g + (size_t)l * DM;
            for (int k = tid; k < DM; k += NWAVES * 64) {
                const float gk = g1[k]; const float* src = Wi + (size_t)k * NIN + 3 * DH;
                const f32x4 a = *(const f32x4*)src, b = *(const f32x4*)(src + 4);
                const int j = k >> 8, ln = (k & 255) >> 2, e = k & 3;
                wf[((j * 4 + e) * 2 + 0) * 64 + ln] = a * gk; wf[((j * 4 + e) * 2 + 1) * 64 + ln] = b * gk;
            }
            __syncthreads();
            const float* fb = forget_b + l * NHF;
            for (int m = gw; m < M; m += NGW) {
                const float* xprev = (l == 0) ? x_in : ((l == 1) ? x_in : XR);
                const f32x4* xr = (const f32x4*)(xprev + (size_t)m * DM) + lane;
                f32x4 v[8]; float ss = 0.f;
#pragma unroll
                for (int j = 0; j < 8; ++j) v[j] = xr[64 * j];
                if (l > 0) {
                    const v2u* dr = (const v2u*)(XN + (size_t)m * DM) + lane; const v2u* er = (const v2u*)(D1 + (size_t)m * DM) + lane; v2u d[8], e[8];
#pragma unroll
                    for (int j = 0; j < 8; ++j) { d[j] = dr[64 * j]; e[j] = er[64 * j]; }
                    f32x4* xw = (f32x4*)(XR + (size_t)m * DM) + lane;
#pragma unroll
                    for (int j = 0; j < 8; ++j) { v[j] = add_bf4(add_bf4(v[j], e[j]), d[j]); xw[64 * j] = v[j]; }
                }
#pragma unroll
                for (int j = 0; j < 8; ++j) ss += (v[j].x * v[j].x + v[j].y * v[j].y) + (v[j].z * v[j].z + v[j].w * v[j].w);
                f32x4 fa = {0.f, 0.f, 0.f, 0.f}, fbv = {0.f, 0.f, 0.f, 0.f};
#pragma unroll
                for (int j = 0; j < 8; ++j) {
#pragma unroll
                    for (int e = 0; e < 4; ++e) { const float xv = v[j][e]; fa += wf[((j * 4 + e) * 2 + 0) * 64 + lane] * xv; fbv += wf[((j * 4 + e) * 2 + 1) * 64 + lane] * xv; }
                    asm volatile("" ::: "memory"); }
                const float rstd = 1.f / sqrtf(wave_sum(ss, lane) * (1.f / DM) + NORM_EPS);
                float f8[8];
#pragma unroll
                for (int e = 0; e < 4; ++e) { f8[e] = wave_sum(fa[e], lane); f8[4 + e] = wave_sum(fbv[e], lane); }
                float fsel = f8[0];
#pragma unroll
                for (int e = 1; e < 8; ++e) fsel = (lane == e) ? f8[e] : fsel;
                if (lane < 8) { const float z = fsel * rstd + fb[lane]; const float ls = fminf(z, 0.f) - __logf(1.f + __expf(-fabsf(z)));
                    LF[((size_t)(m / SEQ) * NHF + lane) * SEQ + (m % SEQ)] = ls; }
                const f32x4* gr = (const f32x4*)g1 + lane;
                v2u* o8 = (v2u*)(XN + (size_t)m * DM) + lane;
#pragma unroll
                for (int j = 0; j < 8; ++j) { const f32x4 g = gr[64 * j]; v2u w; w.x = pk2(v[j].x * rstd * g.x, v[j].y * rstd * g.y); w.y = pk2(v[j].z * rstd * g.z, v[j].w * rstd * g.w); o8[64 * j] = w; }
            }
        }
#endif
        xcd_barrier(xbar, wave_u == 0 && fresh_lane() == 0); STAMP(1 + l * 8 + 0);
#if REPSYNC > 1
        for (int rs_ = 0; rs_ < 8; ++rs_) xcd_barrier(xbar, wave_u == 0 && fresh_lane() == 0);
#endif
#if PHASES & 2
        for (int rep_ = 0; rep_ < REP1; ++rep_) {
            PHASE_PTRS();
            pg8::Gemm g{XN, Win_t, M, NQKV, DM}; pg8::StaticOrder S; S.init(M, NQKV, G, bx, GEMM_WGM);
            pg8::EpiBf16<0> E{QKV, DH, nullptr, DH, QSTR, 1.f};
            pg8::gemm_phase<pg8::EpiBf16<0>, pg8::StaticOrder, true, true>((LAS unsigned char*)lds, g, S, E, wave_u);
        }
#endif
        xcd_barrier(xbar, wave_u == 0 && fresh_lane() == 0); STAMP(1 + l * 8 + 1);
        {
            PHASE_PTRS();
            const swa::bf16* Qa = (const swa::bf16*)QKV; const swa::bf16* Ka = Qa + QSTR; const swa::bf16* Va = Qa + 2 * QSTR;
            const swa::bf16* Qb = Qa + 3 * QSTR; const swa::bf16* Kb = Qa + 4 * QSTR; const swa::bf16* Vb = Qa + 5 * QSTR;
#if PHASES & 4
            for (int rep_ = 0; rep_ < REP2A; ++rep_) {
                const int nitems = (vcu < 256) ? (255 - vcu) / G + 1 : 0, nblk = 2 * nitems;
                auto ref = [&](int k) { const int item = vcu + (k >> 1) * G, bh = item >> 3, y = item & 7, qb = (k & 1) ? 15 - y : y, b = bh >> 3, h = bh & 7;
                    const size_t off = (size_t)b * SEQ * DH + h * HD;
                    swa::BlockRef r; r.Q = Qa + off; r.K = Ka + off; r.V = Va + off; r.O = (swa::bf16*)YA + off; r.L = nullptr; r.aux = LF + (size_t)bh * SEQ;
                    r.P0 = qb * 256; r.skv = SEQ; r.W = 1 << 30; r.pad = 0; return r; };
                for (int k = 0; k < nblk; ++k) { const swa::BlockRef cur = ref(k); swa::swa_block<1, true, DH>(cur, (char*)lds, wave_u); }
            }
#endif
#if PHASES & 8
#define DIL_STREAM(P_, DIL_) do { constexpr int NB = 512; const int per = (NB + G - 1) / G, first = vcu * per, last = (first + per < NB) ? first + per : NB; \
                auto ref = [&](int g) { const int bh = (g >> 4) & 31, j = g & 15, b = bh >> 3, h = bh & 7; constexpr int nbr = 16 / DIL_; const int res = j / nbr, blk = j % nbr; \
                    const size_t off = ((size_t)b * SEQ + res) * DH + h * HD; \
                    swa::BlockRef r; r.Q = Qb + off; r.K = Kb + off; r.V = Vb + off; r.O = (swa::bf16*)OP + (size_t)P_ * QSTR + off; \
                    r.L = LSE + ((size_t)P_ * M + (size_t)b * SEQ + res) * 8 + h; r.aux = BT + (size_t)(P_ * 8 + h) * swa::TABN; \
                    r.P0 = blk * 256; r.skv = SEQ / DIL_; r.W = 129; r.pad = 0; return r; }; \
                for (int g = first; g < last; ++g) { const swa::BlockRef cur = ref(g); swa::swa_block<2, true, DH * DIL_>(cur, (char*)lds, wave_u); } } while (0)
            for (int rep_ = 0; rep_ < REP2B; ++rep_) { DIL_STREAM(0, 1); DIL_STREAM(1, 4); DIL_STREAM(2, 16); }
#undef DIL_STREAM
#endif
        }
        xcd_barrier(xbar, wave_u == 0 && fresh_lane() == 0); STAMP(1 + l * 8 + 2);
#if PHASES & 16
        for (int rep_ = 0; rep_ < REP3; ++rep_) {
            PHASE_IDS(); PHASE_PTRS();
            const float* ga = ona_g + (size_t)l * DH; const float* gb = onb_g + (size_t)l * DH;
            for (int m = gw; m < M; m += NGW) {
                const int h = lane >> 3;
                const float l0 = LSE[((size_t)0 * M + m) * 8 + h], l1 = LSE[((size_t)1 * M + m) * 8 + h], l2 = LSE[((size_t)2 * M + m) * 8 + h];
                const float mx = fmaxf(l0, fmaxf(l1, l2)); float a0 = __expf(l0 - mx), a1 = __expf(l1 - mx), a2 = __expf(l2 - mx);
                const float inv = 1.f / (a0 + a1 + a2); a0 *= inv; a1 *= inv; a2 *= inv;
                const v4u* ya = (const v4u*)(YA + (size_t)m * DH) + 2 * lane;
                const v4u* o0 = (const v4u*)(OP + (size_t)m * DH) + 2 * lane; const v4u* o1 = (const v4u*)(OP + QSTR + (size_t)m * DH) + 2 * lane; const v4u* o2 = (const v4u*)(OP + 2 * QSTR + (size_t)m * DH) + 2 * lane;
                float va[16], vb[16]; float sa = 0.f, sb = 0.f;
#pragma unroll
                for (int q = 0; q < 2; ++q) { const v4u ua = ya[q], u0 = o0[q], u1 = o1[q], u2 = o2[q];
#pragma unroll
                    for (int e = 0; e < 4; ++e) {
                        const float alo = __builtin_bit_cast(float, ua[e] << 16), ahi = __builtin_bit_cast(float, ua[e] & 0xffff0000u);
                        const float blo = a0 * __builtin_bit_cast(float, u0[e] << 16) + a1 * __builtin_bit_cast(float, u1[e] << 16) + a2 * __builtin_bit_cast(float, u2[e] << 16);
                        const float bhi = a0 * __builtin_bit_cast(float, u0[e] & 0xffff0000u) + a1 * __builtin_bit_cast(float, u1[e] & 0xffff0000u) + a2 * __builtin_bit_cast(float, u2[e] & 0xffff0000u);
                        va[q * 8 + 2 * e] = alo; va[q * 8 + 2 * e + 1] = ahi; vb[q * 8 + 2 * e] = blo; vb[q * 8 + 2 * e + 1] = bhi;
                        sa += alo * alo + ahi * ahi; sb += blo * blo + bhi * bhi; } }
                const float ra = 1.f / sqrtf(wave_sum(sa, lane) * (1.f / DH) + NORM_EPS), rb = 1.f / sqrtf(wave_sum(sb, lane) * (1.f / DH) + NORM_EPS);
                const f32x4* gar = (const f32x4*)ga + 4 * lane; const f32x4* gbr = (const f32x4*)gb + 4 * lane;
                v4u* oa = (v4u*)(XN + (size_t)m * DM) + 2 * lane; v4u* ob = (v4u*)(XN + (size_t)m * DM + DH) + 2 * lane;
#pragma unroll
                for (int q = 0; q < 2; ++q) { const f32x4 g0 = gar[2 * q], g1 = gar[2 * q + 1], h0 = gbr[2 * q], h1 = gbr[2 * q + 1];
                    v4u wa, wb;
                    wa.x = pk2(va[q * 8 + 0] * ra * g0.x, va[q * 8 + 1] * ra * g0.y); wa.y = pk2(va[q * 8 + 2] * ra * g0.z, va[q * 8 + 3] * ra * g0.w);
                    wa.z = pk2(va[q * 8 + 4] * ra * g1.x, va[q * 8 + 5] * ra * g1.y); wa.w = pk2(va[q * 8 + 6] * ra * g1.z, va[q * 8 + 7] * ra * g1.w);
                    wb.x = pk2(vb[q * 8 + 0] * rb * h0.x, vb[q * 8 + 1] * rb * h0.y); wb.y = pk2(vb[q * 8 + 2] * rb * h0.z, vb[q * 8 + 3] * rb * h0.w);
                    wb.z = pk2(vb[q * 8 + 4] * rb * h1.x, vb[q * 8 + 5] * rb * h1.y); wb.w = pk2(vb[q * 8 + 6] * rb * h1.z, vb[q * 8 + 7] * rb * h1.w);
                    oa[q] = wa; ob[q] = wb; }
            }
        }
#endif
        xcd_barrier(xbar, wave_u == 0 && fresh_lane() == 0); STAMP(1 + l * 8 + 3);
#if PHASES & 32
        {
            PHASE_PTRS();
            pg8::Gemm g{XN, Wout_t, M, DM, DM}; pg8::StaticOrder S; S.init(M, DM, G, bx, GEMM_WGM);
#if REP4 > 1
            { pg8::EpiNull EN; pg8::gemm_phase<pg8::EpiNull, pg8::StaticOrder, true, true>((LAS unsigned char*)lds, g, S, EN, wave_u); }
#endif
            pg8::EpiBf16<0> E{D1, DM, nullptr, 0, 0, 1.f};
            pg8::gemm_phase<pg8::EpiBf16<0>, pg8::StaticOrder, true, true>((LAS unsigned char*)lds, g, S, E, wave_u);
        }
#endif
        xcd_barrier(xbar, wave_u == 0 && fresh_lane() == 0); STAMP(1 + l * 8 + 4);
#if PHASES & 64
        for (int rep_ = 0; rep_ < REP5; ++rep_) {
            PHASE_IDS(); PHASE_PTRS(); const float* xsrc = (l == 0) ? x_in : XR;
            const float* g2 = norm2_g + (size_t)l * DM;
            for (int m = gw; m < M; m += NGW) {
                const f32x4* xr = (const f32x4*)(xsrc + (size_t)m * DM) + lane;
                const v2u* dr = (const v2u*)(D1 + (size_t)m * DM) + lane;
                f32x4 v[8]; v2u d[8]; float ss = 0.f;
#pragma unroll
                for (int j = 0; j < 8; ++j) { v[j] = xr[64 * j]; d[j] = dr[64 * j]; }
#pragma unroll
                for (int j = 0; j < 8; ++j) { v[j] = add_bf4(v[j], d[j]); ss += (v[j].x * v[j].x + v[j].y * v[j].y) + (v[j].z * v[j].z + v[j].w * v[j].w); }
                const float rstd = 1.f / sqrtf(wave_sum(ss, lane) * (1.f / DM) + NORM_EPS);
                const f32x4* gr = (const f32x4*)g2 + lane;
                v2u* o8 = (v2u*)(XN + (size_t)m * DM) + lane;
#pragma unroll
                for (int j = 0; j < 8; ++j) { const f32x4 g = gr[64 * j]; v2u w; w.x = pk2(v[j].x * rstd * g.x, v[j].y * rstd * g.y); w.y = pk2(v[j].z * rstd * g.z, v[j].w * rstd * g.w); o8[64 * j] = w; }
            }
        }
#endif
        xcd_barrier(xbar, wave_u == 0 && fresh_lane() == 0); STAMP(1 + l * 8 + 5);
#if PHASES & 128
        for (int rep_ = 0; rep_ < REP6; ++rep_) {
            PHASE_PTRS();
            pg8::Gemm g{XN, W1_t, M, DFF, DM}; pg8::StaticOrder S; S.init(M, DFF, G, bx, GEMM_WGM);
#if REP6N > 1
            { pg8::EpiNull EN; pg8::gemm_phase<pg8::EpiNull, pg8::StaticOrder, true, true>((LAS unsigned char*)lds, g, S, EN, wave_u); }
#endif
            pg8::EpiBf16<2> E{HB, DFF, nullptr, 0, 0, 1.f};
            pg8::gemm_phase<pg8::EpiBf16<2>, pg8::StaticOrder, true, true>((LAS unsigned char*)lds, g, S, E, wave_u);
        }
#endif
        xcd_barrier(xbar, wave_u == 0 && fresh_lane() == 0); STAMP(1 + l * 8 + 6);
#if PHASES & 256
        {
            PHASE_PTRS();
            pg8::Gemm g{HB, W2_t, M, DM, DFF}; pg8::StaticOrder S; S.init(M, DM, G, bx, GEMM_WGM);
#if REP7 == 2
            { pg8::EpiNull EN; pg8::gemm_phase<pg8::EpiNull, pg8::StaticOrder, true, true>((LAS unsigned char*)lds, g, S, EN, wave_u); }
#endif
            pg8::EpiBf16<0> E{XN, DM, nullptr, 0, 0, 1.f};
            pg8::gemm_phase<pg8::EpiBf16<0>, pg8::StaticOrder, true, true>((LAS unsigned char*)lds, g, S, E, wave_u);
        }
#endif
        xcd_barrier(xbar, wave_u == 0 && fresh_lane() == 0); STAMP(1 + l * 8 + 7);
    }
    { PHASE_IDS(); PHASE_PTRS();
    for (int m = gw; m < M; m += NGW) {
        f32x4* xr = (f32x4*)(XR + (size_t)m * DM) + lane;
        const v2u* dr = (const v2u*)(XN + (size_t)m * DM) + lane; const v2u* er = (const v2u*)(D1 + (size_t)m * DM) + lane;
        f32x4 v[8]; v2u d[8], e[8]; float ss = 0.f;
#pragma unroll
        for (int j = 0; j < 8; ++j) { v[j] = xr[64 * j]; d[j] = dr[64 * j]; e[j] = er[64 * j]; }
#pragma unroll
        for (int j = 0; j < 8; ++j) { v[j] = add_bf4(add_bf4(v[j], e[j]), d[j]); ss += (v[j].x * v[j].x + v[j].y * v[j].y) + (v[j].z * v[j].z + v[j].w * v[j].w); }
        const float rstd = 1.f / sqrtf(wave_sum(ss, lane) * (1.f / DM) + NORM_EPS);
        const f32x4* gr = (const f32x4*)final_g + lane;
#pragma unroll
        for (int j = 0; j < 8; ++j) xr[64 * j] = v[j] * rstd * gr[64 * j];
    }
    }
#ifdef DIAG
    grid.sync(); STAMP(17);
    if (blockIdx.x == 0 && threadIdx.x < 64) {
        __threadfence();
        const float t1 = (float)(TS[DIAG_B1] - TS[DIAG_A1]) * 0.01f, t2 = (float)(TS[DIAG_B2] - TS[DIAG_A2]) * 0.01f;
        if (threadIdx.x == 0) XR[0] = t1;
        for (int i = threadIdx.x; i < 4096; i += 64) XR[64 + i] = t2;
    }
#endif
}

extern "C" void kernel_launch(void* const* d_in, const int* in_sizes, int n_in, void* d_out, int out_size, void* d_ws, size_t ws_size, hipStream_t stream) {
    static int grid = 0;
    if (grid == 0) {
        if (n_in != 12 || out_size != M * DM || ws_size < WS_END) { fprintf(stderr, "kernel_launch: unexpected shapes (n_in %d out %d ws %zu)\n", n_in, out_size, ws_size); grid = -1; return; }
        int dev = 0, cus = 0, per_cu = 0;
        (void)hipGetDevice(&dev); (void)hipDeviceGetAttribute(&cus, hipDeviceAttributeMultiprocessorCount, dev);
        if (hipFuncSetAttribute((const void*)hymba_fwd, hipFuncAttributeMaxDynamicSharedMemorySize, LDS_BYTES) != hipSuccess) { fprintf(stderr, "kernel_launch: hipFuncSetAttribute failed\n"); grid = -1; return; }
        if (hipOccupancyMaxActiveBlocksPerMultiprocessor(&per_cu, (const void*)hymba_fwd, NWAVES * 64, LDS_BYTES) != hipSuccess || per_cu < 1) { fprintf(stderr, "kernel_launch: occupancy query gives %d\n", per_cu); per_cu = 1; }
        (void)hipGetLastError();
        grid = cus * 1;
        if (grid <= 0) grid = 256;
    }
    if (grid < 0) return;
    if (hipMemsetAsync(d_ws, 0, 16384, stream) != hipSuccess) { fprintf(stderr, "kernel_launch: hipMemsetAsync failed\n"); return; }
    Args a{};
    for (int i = 0; i < 12; ++i) a.in[i] = (const float*)d_in[i];
    a.out = (float*)d_out; a.ws = (unsigned char*)d_ws;
    void* kargs[] = {&a};
    hipError_t e = hipLaunchCooperativeKernel((const void*)hymba_fwd, dim3(grid), dim3(NWAVES * 64), kargs, LDS_BYTES, stream);
    if (e != hipSuccess) fprintf(stderr, "kernel_launch: cooperative launch failed: %s (grid %d)\n", hipGetErrorString(e), grid);
}
```

```cpp
#include <hip/hip_runtime.h>
#include <hip/hip_cooperative_groups.h>
#include <hip/hip_bf16.h>
#include <cstdio>
#include <cstdint>
#include <cmath>
#ifndef PHASES
#define PHASES 511
#endif
#ifndef REP0
#define REP0 1
#endif
#ifndef REP1
#define REP1 1
#endif
#ifndef REP2A
#define REP2A 1
#endif
#ifndef REP2B
#define REP2B 1
#endif
#ifndef REP3
#define REP3 1
#endif
#ifndef REP5
#define REP5 1
#endif
#ifndef REP6
#define REP6 1
#endif
#ifndef REP7
#define REP7 1
#endif
#ifndef REP4
#define REP4 1
#endif
#ifndef REPSYNC
#define REPSYNC 1
#endif
#ifndef REP6N
#define REP6N 1
#endif
__device__ __forceinline__ int fresh_lane() { unsigned z = 0u; asm volatile("" : "+s"(z)); return (int)__builtin_amdgcn_mbcnt_hi(~0u, __builtin_amdgcn_mbcnt_lo(~0u, z)); }
namespace pg8 {
#define PG8_LAS __attribute__((address_space(3)))
typedef unsigned short bf16_t;
typedef short bf16x8 __attribute__((ext_vector_type(8)));
typedef float f32x4 __attribute__((ext_vector_type(4)));
typedef unsigned u32x4 __attribute__((ext_vector_type(4)));
constexpr int BM = 256, BK = 64, HALF = 128, HTB = HALF * BK * 2  , STAGE_BYTES = 8 * HTB, NXCD = 8, WGM = 8;

__host__ __device__ __forceinline__ int lds_byte(int r, int c) { const int st = (r >> 4) * 2 + (c >> 5), rr = r & 15, cc = c & 31, ob = rr * 64 + cc * 2; return st * 1024 + (ob ^ (((ob >> 9) & 1) << 5)); }
__host__ __device__ __forceinline__ void stage_rc(int b, int& R, int& C) { const int st = b / 1024, sb = b % 1024, swz = sb ^ (((sb >> 9) & 1) << 5); R = (st >> 1) * 16 + swz / 64; C = (st & 1) * 32 + (swz % 64) / 2; }
__host__ __device__ __forceinline__ int perm32(int rho) { const int n = rho >> 4, i = rho & 15; return 8 * (i >> 2) + 4 * n + (i & 3); }

struct Unit { int pm, pn; };
struct Gemm { const bf16_t* A; const bf16_t* Bt; int M, N, K; };

struct StaticOrder {
    int nM, nN, nwg, G, c, wgm;
    __host__ __device__ void init(int M, int N, int G_, int c_, int wgm_ = WGM) { nM = M / BM; nN = N / BM; nwg = nM * nN; G = G_; c = c_; wgm = wgm_; }
    __host__ __device__ bool next(int i, Unit& u) const {
        const long L = (long)i * G + c; if (L >= nwg) return false;
        int wgid = (int)L; { const int q = nwg / NXCD, r = nwg % NXCD, xcd = wgid % NXCD, off = wgid / NXCD; wgid = (xcd < r ? xcd * (q + 1) : r * (q + 1) + (xcd - r) * q) + off; }
        const int nig = wgm * nN, gid = wgid / nig, fm = gid * wgm, gsz = (nM - fm) < wgm ? (nM - fm) : wgm;
        u.pm = fm + ((wgid % nig) % gsz); u.pn = (wgid % nig) / gsz; return true;
    }
    __device__ __forceinline__ void a_ready(const Unit&) const {}
    __device__ __forceinline__ void done(const Unit&) const {}
};

__device__ __forceinline__ unsigned cvt_pk_bf16(float lo, float hi) { unsigned r; asm volatile("v_cvt_pk_bf16_f32 %0, %1, %2" : "=v"(r) : "v"(lo), "v"(hi)); return r; }
typedef float f32x2 __attribute__((ext_vector_type(2)));
__device__ __forceinline__ f32x2 gelu_pk(f32x2 v) {
    const f32x2 av = __builtin_elementwise_abs(v), d = av * 0.2316418882f + 1.0f;
    f32x2 t; t.x = __builtin_amdgcn_rcpf(d.x); t.y = __builtin_amdgcn_rcpf(d.y);
    f32x2 q = t * 0.5307027145f + (-0.7265760135f); q = q * t + 0.7107068705f; q = q * t + (-0.142248368f); q = q * t + 0.127414796f; q = q * t;
    const f32x2 s = (v * v) * (-0.72134752044f);
    f32x2 e; e.x = __builtin_amdgcn_exp2f(s.x); e.y = __builtin_amdgcn_exp2f(s.y);
    const f32x2 m = v * (q * e), r = v - m;
    f32x2 o; o.x = v.x < 0.f ? m.x : r.x; o.y = v.y < 0.f ? m.y : r.y; return o;
}

template <int ACT  > struct EpiBf16 {
    static constexpr bool PERM = true, AFTER_DRAIN = false; static_assert(ACT == 0 || ACT == 1 || ACT == 2, "EpiBf16: ACT is 0 (none), 1 (gelu_pk) or 2 (squared relu)");
    bf16_t* O; int ldc; const float* bias; int split_cols; size_t split_stride; float scale0;
    __device__ __forceinline__ void operator()(const f32x4 (&acc)[2][2][4][2], const Unit& u, int wr, int wc, int fr, int fq) const {
        const int row0 = u.pm * BM + wr * 64 + fr; int colt = u.pn * BM; bf16_t* base = O;
        float sc = 1.f; if (split_cols) { const int t = colt / split_cols; base += (size_t)t * split_stride; colt -= t * split_cols; if (t == 0) sc = scale0; }
        const int col0 = colt + wc * 32 + 8 * fq, bcol0 = u.pn * BM + wc * 32 + 8 * fq;
        f32x4 bv[2][2];
#pragma unroll
        for (int bj = 0; bj < 2; ++bj)
#pragma unroll
            for (int n = 0; n < 2; ++n) bv[bj][n] = bias ? *(const f32x4*)(bias + bcol0 + bj * HALF + 4 * n) : (f32x4){0.f, 0.f, 0.f, 0.f};
#pragma unroll
        for (int ai = 0; ai < 2; ++ai)
#pragma unroll
            for (int m = 0; m < 4; ++m) { bf16_t* rowp = base + (size_t)(row0 + ai * HALF + m * 16) * ldc + col0;
#pragma unroll
                for (int bj = 0; bj < 2; ++bj) { f32x4 v0 = acc[ai][bj][m][0] + bv[bj][0], v1 = acc[ai][bj][m][1] + bv[bj][1];
                    if (ACT == 1) { f32x2 a = gelu_pk((f32x2){v0[0], v0[1]}), b = gelu_pk((f32x2){v0[2], v0[3]}), c = gelu_pk((f32x2){v1[0], v1[1]}), d = gelu_pk((f32x2){v1[2], v1[3]});
                        v0 = (f32x4){a.x, a.y, b.x, b.y}; v1 = (f32x4){c.x, c.y, d.x, d.y}; }
                    if (ACT == 2) { v0 = __builtin_elementwise_max(v0, (f32x4){0.f, 0.f, 0.f, 0.f}); v1 = __builtin_elementwise_max(v1, (f32x4){0.f, 0.f, 0.f, 0.f}); v0 = v0 * v0; v1 = v1 * v1; }
                    v0 = v0 * sc; v1 = v1 * sc; u32x4 w; w.x = cvt_pk_bf16(v0[0], v0[1]); w.y = cvt_pk_bf16(v0[2], v0[3]); w.z = cvt_pk_bf16(v1[0], v1[1]); w.w = cvt_pk_bf16(v1[2], v1[3]);
                    *(u32x4*)(rowp + bj * HALF) = w; } }
    }
};

struct EpiResF32 {
    static constexpr bool PERM = false, AFTER_DRAIN = false;
    const float* base; float* out; int ldc; float sc;
    __device__ __forceinline__ void operator()(const f32x4 (&acc)[2][2][4][2], const Unit& u, int wr, int wc, int fr, int fq) const {
        const int col0 = u.pn * BM + wc * 32 + 4 * fq;
#pragma unroll
        for (int ai = 0; ai < 2; ++ai)
#pragma unroll
            for (int m = 0; m < 4; ++m) { const size_t off = (size_t)(u.pm * BM + ai * HALF + wr * 64 + m * 16 + fr) * ldc + col0;
                f32x4 bs[2][2];
#pragma unroll
                for (int bj = 0; bj < 2; ++bj)
#pragma unroll
                    for (int n = 0; n < 2; ++n) bs[bj][n] = *(const f32x4*)(base + off + bj * HALF + n * 16);
#pragma unroll
                for (int bj = 0; bj < 2; ++bj)
#pragma unroll
                    for (int n = 0; n < 2; ++n) *(f32x4*)(out + off + bj * HALF + n * 16) = bs[bj][n] + acc[ai][bj][m][n] * sc;
            }
    }
};
struct EpiNull {
    static constexpr bool PERM = false, AFTER_DRAIN = false;
    __device__ __forceinline__ void operator()(const f32x4 (&acc)[2][2][4][2], const Unit& u, int wr, int wc, int fr, int fq) const {
        f32x4 s = {0.f, 0.f, 0.f, 0.f};
#pragma unroll
        for (int ai = 0; ai < 2; ++ai)
#pragma unroll
            for (int bj = 0; bj < 2; ++bj)
#pragma unroll
                for (int m = 0; m < 4; ++m)
#pragma unroll
                    for (int n = 0; n < 2; ++n) s += acc[ai][bj][m][n];
        asm volatile("" :: "v"(s));
    }
};

struct EpiQKVn {
    static constexpr bool PERM = true, AFTER_DRAIN = false;
    bf16_t* O; int ldc; size_t split_stride; float* ksq; int seq;
    __device__ __forceinline__ void operator()(const f32x4 (&acc)[2][2][4][2], const Unit& u, int wr, int wc, int fr, int fq) const {
        const int row0 = u.pm * BM + wr * 64 + fr; int colt = u.pn * BM; const int t = colt / ldc; colt -= t * ldc;
        bf16_t* base = O + (size_t)t * split_stride; const int col0 = colt + wc * 32 + 8 * fq;
        const int lane = fr + 16 * fq;
#pragma unroll
        for (int ai = 0; ai < 2; ++ai)
#pragma unroll
            for (int m = 0; m < 4; ++m) { const int row = row0 + ai * HALF + m * 16; bf16_t* rowp = base + (size_t)row * ldc + col0;
#pragma unroll
                for (int bj = 0; bj < 2; ++bj) { const f32x4 v0 = acc[ai][bj][m][0], v1 = acc[ai][bj][m][1];
                    u32x4 w; w.x = cvt_pk_bf16(v0[0], v0[1]); w.y = cvt_pk_bf16(v0[2], v0[3]); w.z = cvt_pk_bf16(v1[0], v1[1]); w.w = cvt_pk_bf16(v1[2], v1[3]);
                    *(u32x4*)(rowp + bj * HALF) = w;
                    if (t == 1) {
                        float sq = (v0[0] * v0[0] + v0[1] * v0[1]) + (v0[2] * v0[2] + v0[3] * v0[3]) + (v1[0] * v1[0] + v1[1] * v1[1]) + (v1[2] * v1[2] + v1[3] * v1[3]);
                        sq += __builtin_bit_cast(float, __builtin_amdgcn_ds_bpermute((lane ^ 16) << 2, __builtin_bit_cast(int, sq)));
                        sq += __builtin_bit_cast(float, __builtin_amdgcn_ds_bpermute((lane ^ 32) << 2, __builtin_bit_cast(int, sq)));
                        if (fq == 0) { const int b = row / seq, head = (colt >> 7) + bj; atomicAdd(ksq + ((size_t)(b * 8 + head) * seq + (row - b * seq)), sq); }
                    } } }
    }
};
template <class Epi, class Sched, bool ALIGN_EPI = false, bool SP2 = false>
__device__ __forceinline__ void gemm_phase(PG8_LAS unsigned char* lds, const Gemm g, const Sched& S, const Epi& E, const int wave_u) {
    int tid = wave_u * 64 + fresh_lane(); asm volatile("" : "+v"(tid));
    const int wid = __builtin_amdgcn_readfirstlane(tid >> 6), lane = tid & 63, wr = wid >> 2, wc = wid & 3, fr = lane & 15, fq = lane >> 4;
    const int K = g.K, nt = K / BK;
    unsigned voffA[2], voffB[2];
#pragma unroll
    for (int i = 0; i < 2; ++i) { int R, C; stage_rc(tid * 16 + i * 8192, R, C); const int Rb = Epi::PERM ? ((R & ~31) + perm32(R & 31)) : R;
        voffA[i] = (unsigned)(R * K + C) * 2u; voffB[i] = (unsigned)(Rb * K + C) * 2u; }
    const size_t kstep = (size_t)(BK * 2);
    const size_t hstep = (size_t)HALF * K * 2;
    const size_t tstep = 2 * hstep;
    const unsigned ldsw = (unsigned)wid * 1024u;
    const int aoff = lds_byte(wr * 64 + fr, fq * 8), boff = lds_byte(wc * 32 + fr, fq * 8);
#define PG8_SA(b, h) (((b) * 2 + (h)) * HTB)
#define PG8_SB(b, h) ((4 + (b) * 2 + (h)) * HTB)
#define PG8_STAGE(bufoff, gbase, voff) do { _Pragma("unroll") for (int _i = 0; _i < 2; ++_i) \
        __builtin_amdgcn_global_load_lds((const unsigned*)((const char*)(gbase) + (voff)[_i]), (PG8_LAS unsigned*)(lds + (bufoff) + ldsw + _i * 8192), 16, 0, 0); } while (0)
#define PG8_LDA(dst, b, h) do { _Pragma("unroll") for (int m = 0; m < 4; ++m) _Pragma("unroll") for (int k = 0; k < 2; ++k) dst[m][k] = *(const PG8_LAS bf16x8*)(lds + PG8_SA(b, h) + aoff + m * 2048 + k * 1024); } while (0)
#define PG8_LDB(dst, b, h) do { _Pragma("unroll") for (int n = 0; n < 2; ++n) _Pragma("unroll") for (int k = 0; k < 2; ++k) dst[n][k] = *(const PG8_LAS bf16x8*)(lds + PG8_SB(b, h) + boff + n * 2048 + k * 1024); } while (0)
#define PG8_MMA(ai, bj, At, Bt) do { __builtin_amdgcn_s_setprio(1); _Pragma("unroll") for (int m = 0; m < 4; ++m) _Pragma("unroll") for (int n = 0; n < 2; ++n) _Pragma("unroll") for (int k = 0; k < 2; ++k) \
        acc[ai][bj][m][n] = __builtin_amdgcn_mfma_f32_16x16x32_bf16(Bt[n][k], At[m][k], acc[ai][bj][m][n], 0, 0, 0); __builtin_amdgcn_s_setprio(0); } while (0)
#define PG8_WAIT_V(n) asm volatile("s_waitcnt vmcnt(" #n ")" ::: "memory")
#define PG8_WAIT_L(n) asm volatile("s_waitcnt lgkmcnt(" #n ")" ::: "memory")
#define PG8_BAR __builtin_amdgcn_s_barrier()
#define PG8_SCHED __builtin_amdgcn_sched_barrier(0)
    Unit cur, nxt; int ui = 0;
    if (!S.next(0, cur)) return;
    f32x4 acc[2][2][4][2];
#pragma unroll
    for (int a = 0; a < 2; ++a)
#pragma unroll
        for (int b = 0; b < 2; ++b)
#pragma unroll
            for (int m = 0; m < 4; ++m)
#pragma unroll
                for (int n = 0; n < 2; ++n) acc[a][b][m][n] = (f32x4){0.f, 0.f, 0.f, 0.f};
    bf16x8 At[4][2], B0[2][2], B1[2][2];
    const char* cA = (const char*)g.A + (size_t)cur.pm * tstep; const char* cB = (const char*)g.Bt + (size_t)cur.pn * tstep;
    S.a_ready(cur);
    if constexpr (SP2) {
        PG8_STAGE(PG8_SB(0, 0), cB, voffB); PG8_STAGE(PG8_SB(0, 1), cB + hstep, voffB); PG8_STAGE(PG8_SA(0, 0), cA, voffA); PG8_STAGE(PG8_SA(0, 1), cA + hstep, voffA);
        if (wr == 1) PG8_BAR;
        PG8_WAIT_V(2); PG8_BAR;
        PG8_STAGE(PG8_SB(1, 0), cB + kstep, voffB); PG8_STAGE(PG8_SA(1, 0), cA + kstep, voffA); PG8_STAGE(PG8_SB(1, 1), cB + hstep + kstep, voffB);
        PG8_WAIT_V(6); PG8_BAR;
    } else {
        PG8_STAGE(PG8_SB(0, 0), cB, voffB); PG8_STAGE(PG8_SA(0, 0), cA, voffA); PG8_STAGE(PG8_SB(0, 1), cB + hstep, voffB); PG8_STAGE(PG8_SA(0, 1), cA + hstep, voffA);
        if (wr == 1) PG8_BAR;
        PG8_WAIT_V(4); PG8_BAR;
        PG8_STAGE(PG8_SB(1, 0), cB + kstep, voffB); PG8_STAGE(PG8_SA(1, 0), cA + kstep, voffA); PG8_STAGE(PG8_SB(1, 1), cB + hstep + kstep, voffB);
        PG8_WAIT_V(6); PG8_BAR;
    }
    for (;;) {
        const bool has_next = S.next(ui + 1, nxt);
        const char* nA = has_next ? (const char*)g.A + (size_t)nxt.pm * tstep : cA; const char* nB = has_next ? (const char*)g.Bt + (size_t)nxt.pn * tstep : cB;
        for (int t = 0; t < nt; t += 2) {
            const bool last = (t == nt - 2);
            const char* a1 = cA + (size_t)(t + 1) * kstep;
            const char* a2 = last ? nA : cA + (size_t)(t + 2) * kstep; const char* b2 = last ? nB : cB + (size_t)(t + 2) * kstep;
            const char* a3 = a2 + kstep; const char* b3 = b2 + kstep;
            if (last && has_next) S.a_ready(nxt);
            if constexpr (SP2) {
            PG8_LDB(B0, 0, 0); PG8_LDB(B1, 0, 1); PG8_SCHED; PG8_LDA(At, 0, 0); PG8_STAGE(PG8_SA(1, 1), a1 + hstep, voffA);
            PG8_WAIT_V(8); PG8_WAIT_L(0); PG8_BAR; PG8_MMA(0, 0, At, B0); PG8_MMA(0, 1, At, B1); PG8_BAR; PG8_SCHED;
            PG8_LDA(At, 0, 1); PG8_STAGE(PG8_SB(0, 0), b2, voffB); PG8_STAGE(PG8_SB(0, 1), b2 + hstep, voffB); PG8_STAGE(PG8_SA(0, 0), a2, voffA);
            PG8_WAIT_V(8); PG8_WAIT_L(0); PG8_BAR; PG8_MMA(1, 0, At, B0); PG8_MMA(1, 1, At, B1); PG8_BAR; PG8_SCHED;
            PG8_LDB(B0, 1, 0); PG8_LDB(B1, 1, 1); PG8_SCHED; PG8_LDA(At, 1, 0); PG8_STAGE(PG8_SA(0, 1), a2 + hstep, voffA);
            PG8_WAIT_V(8); PG8_WAIT_L(0); PG8_BAR; PG8_MMA(0, 0, At, B0); PG8_MMA(0, 1, At, B1); PG8_BAR; PG8_SCHED;
            PG8_LDA(At, 1, 1); PG8_STAGE(PG8_SB(1, 0), b3, voffB); PG8_STAGE(PG8_SB(1, 1), b3 + hstep, voffB); PG8_STAGE(PG8_SA(1, 0), a3, voffA);
            PG8_WAIT_V(8); PG8_WAIT_L(0); PG8_BAR; PG8_MMA(1, 0, At, B0); PG8_MMA(1, 1, At, B1); PG8_BAR; PG8_SCHED;
            } else {
            PG8_LDB(B0, 0, 0); PG8_SCHED; PG8_LDA(At, 0, 0); PG8_STAGE(PG8_SA(1, 1), a1 + hstep, voffA);
            PG8_WAIT_L(8); PG8_BAR; PG8_WAIT_L(0); PG8_MMA(0, 0, At, B0); PG8_BAR; PG8_SCHED;
            PG8_LDB(B1, 0, 1); PG8_STAGE(PG8_SB(0, 0), b2, voffB);
            PG8_BAR; PG8_WAIT_L(0); PG8_MMA(0, 1, At, B1); PG8_BAR;
            PG8_LDA(At, 0, 1); PG8_STAGE(PG8_SA(0, 0), a2, voffA);
            PG8_BAR; PG8_WAIT_L(0); PG8_MMA(1, 0, At, B0); PG8_BAR; PG8_SCHED;
            PG8_STAGE(PG8_SB(0, 1), b2 + hstep, voffB);
            PG8_WAIT_V(6); PG8_BAR; PG8_MMA(1, 1, At, B1); PG8_BAR;
            PG8_LDB(B0, 1, 0); PG8_SCHED; PG8_LDA(At, 1, 0); PG8_STAGE(PG8_SA(0, 1), a2 + hstep, voffA);
            PG8_WAIT_L(8); PG8_BAR; PG8_WAIT_L(0); PG8_MMA(0, 0, At, B0); PG8_BAR; PG8_SCHED;
            PG8_LDB(B1, 1, 1); PG8_STAGE(PG8_SB(1, 0), b3, voffB);
            PG8_BAR; PG8_WAIT_L(0); PG8_MMA(0, 1, At, B1); PG8_BAR;
            PG8_LDA(At, 1, 1); PG8_STAGE(PG8_SA(1, 0), a3, voffA);
            PG8_BAR; PG8_WAIT_L(0); PG8_MMA(1, 0, At, B0); PG8_BAR; PG8_SCHED;
            PG8_STAGE(PG8_SB(1, 1), b3 + hstep, voffB);
            PG8_WAIT_V(6); PG8_BAR; PG8_MMA(1, 1, At, B1); PG8_BAR;
            }
        }
        if constexpr (ALIGN_EPI) { if (wr == 0) PG8_BAR; }
        if constexpr (!Epi::AFTER_DRAIN) { E(acc, cur, wr, wc, fr, fq); S.done(cur); }
        if (!has_next) break;
#pragma unroll
        for (int a = 0; a < 2; ++a)
#pragma unroll
            for (int b = 0; b < 2; ++b)
#pragma unroll
                for (int m = 0; m < 4; ++m)
#pragma unroll
                    for (int n = 0; n < 2; ++n) acc[a][b][m][n] = (f32x4){0.f, 0.f, 0.f, 0.f};
        cur = nxt; cA = nA; cB = nB; ++ui;
        if constexpr (ALIGN_EPI) { if (wr == 1) PG8_BAR; }
    }
    PG8_WAIT_V(0);
    if constexpr (!ALIGN_EPI) { if (wr == 0) PG8_BAR; }
    PG8_BAR;
    if constexpr (Epi::AFTER_DRAIN) { E.fused(acc, cur, wr, wc, fr, fq, lds, wid, lane); S.done(cur); }
#undef PG8_SA
#undef PG8_SB
#undef PG8_STAGE
#undef PG8_LDA
#undef PG8_LDB
#undef PG8_MMA
#undef PG8_WAIT_V
#undef PG8_WAIT_L
#undef PG8_BAR
#undef PG8_SCHED
}
}
namespace swa {
constexpr int D = 128;
constexpr float THR = 8.f;
constexpr float SCALE = 0.08838834764831845f;
constexpr int NW = 8, QBLK = 32, KVBLK = 64, QB = NW * QBLK;
constexpr int SHM_V = KVBLK * D * 2, SHM_K = KVBLK * D * 2;
constexpr int NVS = 3;
constexpr int OFF_WS = NVS * SHM_V + 2 * SHM_K;
constexpr int OFF_CS = OFF_WS + NW * 64 * 4;
constexpr int OFF_SC = OFF_CS + 4096 * 8;
constexpr int LDS_BYTES = OFF_SC + 128;
constexpr int TABN = 320, TABOFF = 96;
#ifndef PIPE2
#define PIPE2 0
#endif

using bf16 = __hip_bfloat16;
typedef short bf16x8 __attribute__((ext_vector_type(8)));
typedef short s16x4 __attribute__((ext_vector_type(4)));
typedef float f32x16 __attribute__((ext_vector_type(16)));
typedef float f32x4 __attribute__((ext_vector_type(4)));
typedef unsigned u32x4 __attribute__((ext_vector_type(4)));
typedef unsigned u32x2 __attribute__((ext_vector_type(2)));

#define KSWZ(row, colB) ((row) * 256 + ((colB) ^ (((row) & 7) << 4)))
#define SBAR() __builtin_amdgcn_sched_barrier(0)
__device__ __forceinline__ int v_st(int k, int c) { const int kk = (k & ~0xC) | ((k & 4) << 1) | ((k & 8) >> 1); return ((kk >> 3) * 4 + (c >> 5)) * 512 + ((kk & 7) * 32 + (c & 31)) * 2; }
__device__ __forceinline__ int v_rd_base(int lane) { return ((lane & 3) << 3) | (((lane >> 2) & 3) << 6) | (((lane >> 4) & 1) << 5) | (((lane >> 5) & 1) << 8); }
constexpr int v_rd_off(int d0, int ks, int half) { return d0 * 512 + ks * 4096 + half * 2048; }
__device__ __forceinline__ int crow(int r, int hi) { return (r & 3) + 8 * (r >> 2) + 4 * hi; }
__device__ __forceinline__ unsigned cvtpk(float lo, float hi) { unsigned r; asm volatile("v_cvt_pk_bf16_f32 %0, %1, %2" : "=v"(r) : "v"(lo), "v"(hi)); return r; }
__device__ __forceinline__ bf16x8 load8(const bf16* p) { return *reinterpret_cast<const bf16x8*>(p); }

__device__ __forceinline__ void mask_tile(f32x16& p0, f32x16& p1, int dq, unsigned W) {
    const float NEG = -__builtin_inff();
#pragma unroll
    for (int r = 0; r < 16; ++r) {
        const int c = (r & 3) + 8 * (r >> 2);
        if ((unsigned)(dq - c) >= W) p0[r] = NEG;
        if ((unsigned)(dq - c - 32) >= W) p1[r] = NEG;
    }
}
__device__ __forceinline__ void bias_mask_tile(f32x16& p0, f32x16& p1, int dq, unsigned W, const float* tab) {
    const float NEG = -__builtin_inff();
    const float* tb = tab + TABOFF + dq;
#pragma unroll
    for (int q = 0; q < 4; ++q) {
#pragma unroll
        for (int e = 0; e < 4; ++e) { const int r = 4 * q + e, c = e + 8 * q;
            const float b0 = tb[-c], b1 = tb[-c - 32];
            p0[r] = ((unsigned)(dq - c) >= W) ? NEG : p0[r] + b0;
            p1[r] = ((unsigned)(dq - c - 32) >= W) ? NEG : p1[r] + b1; }
        asm volatile("" ::: "memory");
    }
}
__device__ __forceinline__ void partialSM(f32x16& p0, f32x16& p1, float& m_reg, float& mn, float& alpha) {
    float pmax = p0[0]; for (int r = 1; r < 16; ++r) pmax = fmaxf(pmax, p0[r]); for (int r = 0; r < 16; ++r) pmax = fmaxf(pmax, p1[r]);
    { auto rr = __builtin_amdgcn_permlane32_swap(__float_as_uint(pmax), __float_as_uint(pmax), false, false);
      pmax = fmaxf(__uint_as_float(rr[0]), __uint_as_float(rr[1])); }
    constexpr float C2 = 1.4426950408889634f * SCALE;
    if (__builtin_expect(__all((pmax - m_reg) * SCALE <= THR), 1)) { mn = m_reg; alpha = 1.f; }
    else { mn = fmaxf(m_reg, pmax); alpha = __builtin_amdgcn_exp2f((m_reg - mn) * C2); m_reg = mn; }
    const float mnL = -mn * C2;
    for (int r = 0; r < 16; ++r) p0[r] = fmaf(p0[r], C2, mnL); for (int r = 0; r < 16; ++r) p1[r] = fmaf(p1[r], C2, mnL);
    for (int r = 0; r < 16; ++r) p0[r] = __builtin_amdgcn_exp2f(p0[r]);
}
__device__ __forceinline__ void finishSM(f32x16& p0, f32x16& p1, float alpha, float& l_reg, bf16x8& pa0, bf16x8& pa1, bf16x8& pa2, bf16x8& pa3) {
    for (int r = 0; r < 16; ++r) p1[r] = __builtin_amdgcn_exp2f(p1[r]);
    float ps = 0; for (int r = 0; r < 16; ++r) ps += p0[r]; for (int r = 0; r < 16; ++r) ps += p1[r];
    { auto rr = __builtin_amdgcn_permlane32_swap(__float_as_uint(ps), __float_as_uint(ps), false, false);
      ps = __uint_as_float(rr[0]) + __uint_as_float(rr[1]); }
    l_reg = l_reg * alpha + ps;
#define PK4(P, B_, OUT) do { unsigned a0 = cvtpk(P[B_+0], P[B_+1]), a1 = cvtpk(P[B_+2], P[B_+3]);                          \
        unsigned b0 = cvtpk(P[B_+4], P[B_+5]), b1 = cvtpk(P[B_+6], P[B_+7]);                                             \
        auto r0 = __builtin_amdgcn_permlane32_swap(a0, b0, false, false); auto r1 = __builtin_amdgcn_permlane32_swap(a1, b1, false, false); \
        u32x4 w = {r0[0], r1[0], r0[1], r1[1]}; OUT = *reinterpret_cast<bf16x8*>(&w); } while (0)
    PK4(p0, 0, pa0); PK4(p0, 8, pa1); PK4(p1, 0, pa2); PK4(p1, 8, pa3);
#undef PK4
}
#define KRD(dst, base, off) asm volatile("ds_read_b128 %0, %1 offset:%2" : "=&v"(dst) : "v"(base), "i"(off) : "memory")
#define SB_ALU() __builtin_amdgcn_sched_barrier(0)
template <int KB, bool SK, int MODE>
__device__ __forceinline__ void qkt(f32x16& p0, f32x16& p1, const int* kba, int r32, int hi, const bf16x8* qr, bool act, const unsigned long long* csk, const unsigned long long* csq) {
    if (SK && !act) { const float NEG = -__builtin_inff();
#pragma unroll
        for (int r = 0; r < 16; ++r) { p0[r] = NEG; p1[r] = NEG; } return; }
    constexpr int OB = KB * SHM_K;
    bf16x8 a0, a1, b0, b1;
    KRD(a0, kba[0], OB); KRD(a1, kba[0], OB + 8192); KRD(b0, kba[1], OB); KRD(b1, kba[1], OB + 8192);
    p0 = f32x16{}; p1 = f32x16{};
    if constexpr (MODE == 1) {
        const u32x2 t0 = *(const u32x2*)(csk), t1 = *(const u32x2*)(csk + 32), tq = *(const u32x2*)(csq);
        const u32x4 qv = {0x3f803f80u, 0x00003f80u, tq.x ^ 0x80008000u, tq.y ^ 0x00008000u};
        const bf16x8 qx = hi ? bf16x8{} : __builtin_bit_cast(bf16x8, qv);
        const u32x4 k0 = {t0.x, t0.y, 0x3f803f80u, 0x00003f80u}, k1 = {t1.x, t1.y, 0x3f803f80u, 0x00003f80u};
        p0 = __builtin_amdgcn_mfma_f32_32x32x16_bf16(__builtin_bit_cast(bf16x8, k0), qx, p0, 0, 0, 0);
        p1 = __builtin_amdgcn_mfma_f32_32x32x16_bf16(__builtin_bit_cast(bf16x8, k1), qx, p1, 0, 0, 0);
    }
#define QK_STEP(X0, X1, d0, NB, LD0) do { asm volatile("s_waitcnt lgkmcnt(%0)" :: "i"(NB) : "memory"); SB_ALU(); \
        p0 = __builtin_amdgcn_mfma_f32_32x32x16_bf16(X0, qr[d0], p0, 0, 0, 0); p1 = __builtin_amdgcn_mfma_f32_32x32x16_bf16(X1, qr[d0], p1, 0, 0, 0); SB_ALU(); \
        if (LD0 < 8) { KRD(X0, kba[(LD0) & 3], OB + ((LD0) >> 2) * 128); KRD(X1, kba[(LD0) & 3], OB + ((LD0) >> 2) * 128 + 8192); } } while (0)
    __builtin_amdgcn_s_setprio(1);
    QK_STEP(a0, a1, 0, 2, 2); QK_STEP(b0, b1, 1, 2, 3); QK_STEP(a0, a1, 2, 2, 4); QK_STEP(b0, b1, 3, 2, 5);
    QK_STEP(a0, a1, 4, 2, 6); QK_STEP(b0, b1, 5, 2, 7); QK_STEP(a0, a1, 6, 2, 8); QK_STEP(b0, b1, 7, 0, 9);
    __builtin_amdgcn_s_setprio(0);
#undef QK_STEP
}
template <int VB, bool SK>
__device__ __forceinline__ void pv_tile(f32x16* o, int vb0, bf16x8 pa0, bf16x8 pa1, bf16x8 pa2, bf16x8 pa3, bool act) {
    if (SK && !act) return;
#define TRRD(dst, off) asm volatile("ds_read_b64_tr_b16 %0, %1 offset:%2" : "=&v"(dst) : "v"(vb0), "i"(off) : "memory")
#define PV_D0(d0) do { s16x4 l0, l1, l2, l3, h0, h1, h2, h3; constexpr int b_ = VB * SHM_V + v_rd_off(d0, 0, 0); \
        TRRD(l0, b_); TRRD(h0, b_ + 2048); TRRD(l1, b_ + 4096); TRRD(h1, b_ + 6144); TRRD(l2, b_ + 8192); TRRD(h2, b_ + 10240); TRRD(l3, b_ + 12288); TRRD(h3, b_ + 14336); \
        asm volatile("s_waitcnt lgkmcnt(0)" ::: "memory"); SBAR();   \
        o[d0] = __builtin_amdgcn_mfma_f32_32x32x16_bf16(pa0, (bf16x8){l0[0], l0[1], l0[2], l0[3], h0[0], h0[1], h0[2], h0[3]}, o[d0], 0, 0, 0);   \
        o[d0] = __builtin_amdgcn_mfma_f32_32x32x16_bf16(pa1, (bf16x8){l1[0], l1[1], l1[2], l1[3], h1[0], h1[1], h1[2], h1[3]}, o[d0], 0, 0, 0);   \
        o[d0] = __builtin_amdgcn_mfma_f32_32x32x16_bf16(pa2, (bf16x8){l2[0], l2[1], l2[2], l2[3], h2[0], h2[1], h2[2], h2[3]}, o[d0], 0, 0, 0);   \
        o[d0] = __builtin_amdgcn_mfma_f32_32x32x16_bf16(pa3, (bf16x8){l3[0], l3[1], l3[2], l3[3], h3[0], h3[1], h3[2], h3[3]}, o[d0], 0, 0, 0); } while (0)
    __builtin_amdgcn_s_setprio(1); PV_D0(0); PV_D0(1); PV_D0(2); PV_D0(3); __builtin_amdgcn_s_setprio(0);
#undef PV_D0
#undef TRRD
}

struct BlockRef { const bf16* Q; const bf16* K; const bf16* V; bf16* O; float* L; const float* aux; const float* aux2; int P0, skv, W, pad; };
__device__ __forceinline__ int swa_jlo(int P0, int W) { const int lowk = P0 - W + 1; return lowk > 0 ? lowk / KVBLK : 0; }
#define ROW(p, k0, rr0, rs_) ((const bf16*)((const char*)(p) + (size_t)((k0) + (rr0)) * (size_t)(rs_) * 2 + voff))
#define VMW() asm volatile("s_waitcnt vmcnt(0)" ::: "memory")
#define SLOAD_H(Kp, Vp, k0, rs_) do { st_v0 = load8(ROW(Vp, k0, 0, rs_)); st_v1 = load8(ROW(Vp, k0, 32, rs_));              \
                         st_k0 = load8(ROW(Kp, k0, 0, rs_)); st_k1 = load8(ROW(Kp, k0, 32, rs_)); } while (0)
#define SWRITE_HK(bf) do { *(bf16x8*)(K_lds + (bf) * SHM_K + kws) = st_k0; *(bf16x8*)(K_lds + (bf) * SHM_K + kws + 32 * 256) = st_k1; } while (0)
#define SWRITE_HV(off_) do { *(bf16x8*)(V_lds + (off_) + vst0) = st_v0; *(bf16x8*)(V_lds + (off_) + vst1) = st_v1; } while (0)
template <int MODE, bool SK, int RS>
__device__ __forceinline__ void swa_block(const BlockRef& cur, char* lds, const int wave_u) {
    int tid = wave_u * 64 + fresh_lane(); asm volatile("" : "+v"(tid));
    const int wid = __builtin_amdgcn_readfirstlane(tid >> 6), lane = tid & 63, r32 = lane & 31, hi = lane >> 5;
    const int W = cur.W, skv = cur.skv; constexpr int rs = RS;
    int j_lo = swa_jlo(cur.P0, W);
    int j_hi = (cur.P0 + QB - 1) / KVBLK + 1; if (j_hi > skv / KVBLK) j_hi = skv / KVBLK;
    const int qlo = cur.P0 + wid * QBLK, qm = qlo + r32 - 4 * hi;
    char* V_lds = lds; char* K_lds = lds + NVS * SHM_V;
    float* ws = (float*)(lds + OFF_WS) + wid * 64; float* li_l = ws, * al_l = ws + 32;
    const int sr = tid >> 4, sc = (tid & 15) * 8, vst0 = v_st(sr, sc), vst1 = v_st(32 + sr, sc), kws = KSWZ(sr, sc * 2);
    const unsigned voff = (unsigned)(sr * RS + sc) * 2u, qoff = (unsigned)(r32 * RS + hi * 8) * 2u;
    const int vb0 = (int)(uintptr_t)V_lds + v_rd_base(lane);
    int kba[4];
#pragma unroll
    for (int dd = 0; dd < 4; ++dd) kba[dd] = (int)(uintptr_t)K_lds + KSWZ(r32, (dd * 16 + hi * 8) * 2);
    const bf16* Kh = cur.K; const bf16* Vh = cur.V;
    bf16x8 qr[8], st_v0, st_v1, st_k0, st_k1;
#define KBASE(t) ((j_lo + (t)) * KVBLK)
    { const char* qb_ = (const char*)(cur.Q + (size_t)(cur.P0 + wid * QBLK) * RS);
#pragma unroll
      for (int d0 = 0; d0 < 8; ++d0) qr[d0] = load8((const bf16*)(qb_ + qoff + d0 * 32)); }
    if constexpr (MODE != 1) { SLOAD_H(Kh, Vh, KBASE(0), RS); }
    unsigned long long* cs = (unsigned long long*)(lds + OFF_CS);
    if constexpr (MODE == 1) {
        float* sc8 = (float*)(lds + OFF_SC);
        const int n = cur.P0 + QB; const float* lf = cur.aux;
        f32x4 a = {0.f, 0.f, 0.f, 0.f}, b = {0.f, 0.f, 0.f, 0.f};
        if (8 * tid < n) { a = *(const f32x4*)(lf + 8 * tid); b = *(const f32x4*)(lf + 8 * tid + 4); }
        a[1] += a[0]; a[2] += a[1]; a[3] += a[2]; b[0] += a[3]; b[1] += b[0]; b[2] += b[1]; b[3] += b[2];
        const float tot = b[3]; float inc = tot;
#pragma unroll
        for (int o_ = 1; o_ < 64; o_ <<= 1) { const float v = __builtin_bit_cast(float, __builtin_amdgcn_ds_bpermute((lane - o_) << 2, __builtin_bit_cast(int, inc))); if (lane >= o_) inc += v; }
        if (lane == 63) sc8[wid] = inc;
        __syncthreads();
        float base = inc - tot;
        for (int w = 0; w < wid; ++w) base += sc8[w];
        const float ninv = -1.f / SCALE;
        if (8 * tid < n) {
#pragma unroll
            for (int e = 0; e < 8; ++e) { const float v = ((e < 4 ? a[e & 3] : b[e & 3]) + base) * ninv;
                const unsigned h = cvtpk(v, 0.f) & 0xffffu; const float r1 = v - __uint_as_float(h << 16);
                const unsigned m = cvtpk(r1, 0.f) & 0xffffu; const float r2 = r1 - __uint_as_float(m << 16);
                const unsigned lo = cvtpk(r2, 0.f) & 0xffffu;
                cs[8 * tid + e] = (unsigned long long)(h | (m << 16)) | ((unsigned long long)lo << 32); }
        }
        float kmx = 0.f;
        if (8 * tid < n) { const f32x4 ka = *(const f32x4*)(cur.aux2 + 8 * tid), kb2 = *(const f32x4*)(cur.aux2 + 8 * tid + 4);
            kmx = fmaxf(fmaxf(fmaxf(ka[0], ka[1]), fmaxf(ka[2], ka[3])), fmaxf(fmaxf(kb2[0], kb2[1]), fmaxf(kb2[2], kb2[3]))); }
        float qsq = 0.f;
#pragma unroll
        for (int d0 = 0; d0 < 8; ++d0)
#pragma unroll
            for (int e = 0; e < 8; ++e) { const float qv = __uint_as_float((unsigned)(unsigned short)qr[d0][e] << 16); qsq += qv * qv; }
        { auto rr = __builtin_amdgcn_permlane32_swap(__float_as_uint(qsq), __float_as_uint(qsq), false, false); qsq = __uint_as_float(rr[0]) + __uint_as_float(rr[1]); }
#pragma unroll
        for (int o_ = 1; o_ < 64; o_ <<= 1) { kmx = fmaxf(kmx, __builtin_bit_cast(float, __builtin_amdgcn_ds_bpermute((lane ^ o_) << 2, __builtin_bit_cast(int, kmx))));
                                              qsq = fmaxf(qsq, __builtin_bit_cast(float, __builtin_amdgcn_ds_bpermute((lane ^ o_) << 2, __builtin_bit_cast(int, qsq)))); }
        if (lane == 0) { sc8[8 + wid] = kmx; sc8[16 + wid] = qsq; }
        __syncthreads();
        {   float km = sc8[8], qmx = sc8[16];
#pragma unroll
            for (int w = 1; w < NW; ++w) { km = fmaxf(km, sc8[8 + w]); qmx = fmaxf(qmx, sc8[16 + w]); }
            const float G = 2.04f * sqrtf(km * qmx) + THR / SCALE;
            auto tabv = [&](int s_) { const unsigned long long t_ = cs[s_]; return __uint_as_float((unsigned)t_ << 16) + __uint_as_float((unsigned)t_ & 0xffff0000u) + __uint_as_float((unsigned)(t_ >> 32) << 16); };
            const float v0 = tabv(cur.P0);
            const int jt = lane;
            bool skip = false;
            if (jt < j_hi) skip = (G + tabv(KVBLK * jt + KVBLK - 1) - v0) * (1.4426950408889634f * SCALE) < -160.f;
            const unsigned long long bal = __builtin_amdgcn_ballot_w64(skip);
            int nskip = (~bal == 0ull) ? 64 : __builtin_ctzll(~bal);
            nskip &= ~1;
            if (nskip > j_hi - 4) nskip = (j_hi - 4) & ~1;
            if (nskip < 0) nskip = 0;
            j_lo = __builtin_amdgcn_readfirstlane(nskip);
        }
        SLOAD_H(Kh, Vh, KBASE(0), RS);
    }
    const int NT = j_hi - j_lo;
    if constexpr (MODE == 2) { if (tid < TABN) ((float*)cs)[tid] = cur.aux[tid]; }
    VMW(); SWRITE_HV(0); SWRITE_HK(0);
    __syncthreads();
    float m_reg = -1e30f, l_reg = 0; f32x16 o[4] = {};
#define RESC(a) do { if (__any((a) < 1.f)) { if (hi == 0) al_l[r32] = (a); asm volatile("s_waitcnt lgkmcnt(0)" ::: "memory");              \
                     for (int d_ = 0; d_ < 4; ++d_) for (int r = 0; r < 16; ++r) o[d_][r] *= al_l[crow(r, hi)]; } } while (0)
#define ACT(t) (KBASE(t) <= qlo + QBLK - 1 && KBASE(t) + KVBLK - 1 >= qlo - W + 1)
#define MASKT(P0_, P1_, t) do { const int kb_ = KBASE(t); \
        if constexpr (MODE == 2) { bias_mask_tile(P0_, P1_, qm - kb_, (unsigned)W, (const float*)cs); } \
        else { if (kb_ + KVBLK - 1 > qlo || kb_ <= qlo + QBLK - 1 - W) mask_tile(P0_, P1_, qm - kb_, (unsigned)W); } } while (0)
#define CSK(t) (cs + KBASE(t) + r32)
    const unsigned long long* const qx = cs + cur.P0 + wid * QBLK + r32;
    if constexpr (MODE == 1 || PIPE2) {
    int vs_prev = 0, vs_cur = 0, vs_next = SHM_V;
#define ROTV() do { vs_prev = vs_cur; vs_cur = vs_next; vs_next = (vs_next == (NVS - 1) * SHM_V) ? 0 : vs_next + SHM_V; } while (0)
#define STAGE_BAR(t, BUF) do { \
        if ((t) + 1 < NT) { VMW(); SWRITE_HK((BUF) ^ 1); SWRITE_HV(vs_next); } \
        asm volatile("s_waitcnt vmcnt(0) lgkmcnt(0)\n\ts_barrier" ::: "memory"); \
        if ((t) + 2 < NT) { SLOAD_H(Kh, Vh, KBASE((t) + 2), RS); } SBAR(); ROTV(); } while (0)
    f32x16 pA0, pA1, pB0, pB1; float mnA, mnB, alA, alB; bf16x8 pa0, pa1, pa2, pa3;
    if (NT > 1) { SLOAD_H(Kh, Vh, KBASE(1), RS); } SBAR();
    qkt<0, SK, MODE>(pA0, pA1, kba, r32, hi, qr, ACT(0), CSK(0), qx);
    if (!SK || ACT(0)) MASKT(pA0, pA1, 0);
    partialSM(pA0, pA1, m_reg, mnA, alA);
    STAGE_BAR(0, 0);
#define HALF_STEP(PX0, PX1, mnX, alX, PY0, PY1, alY, t, KB) do { \
        SBAR(); qkt<KB, SK, MODE>(PX0, PX1, kba, r32, hi, qr, ACT(t), CSK(t), qx); \
        finishSM(PY0, PY1, alY, l_reg, pa0, pa1, pa2, pa3); SBAR(); \
        pv_tile<0, SK>(o, vb0 + vs_prev, pa0, pa1, pa2, pa3, ACT((t) - 1)); \
        if (!SK || ACT(t)) MASKT(PX0, PX1, (t)); partialSM(PX0, PX1, m_reg, mnX, alX); \
        RESC(alX); \
        STAGE_BAR(t, KB); } while (0)
    for (int t = 1; t + 1 < NT; t += 2) {
        HALF_STEP(pB0, pB1, mnB, alB, pA0, pA1, alA, t, 1);
        HALF_STEP(pA0, pA1, mnA, alA, pB0, pB1, alB, t + 1, 0);
    }
    HALF_STEP(pB0, pB1, mnB, alB, pA0, pA1, alA, NT - 1, 1);
    finishSM(pB0, pB1, alB, l_reg, pa0, pa1, pa2, pa3); SBAR();
    pv_tile<0, SK>(o, vb0 + vs_prev, pa0, pa1, pa2, pa3, ACT(NT - 1));
#undef HALF_STEP
#undef STAGE_BAR
#undef ROTV
    } else {
    const bool grpB = wid >= 4;
    int vs_cur = 0, vs_next = SHM_V;
    bf16x8 u_v0, u_v1, u_k0, u_k1;
#define SLOAD_U(Kp, Vp, k0, rs_) do { u_v0 = load8(ROW(Vp, k0, 0, rs_)); u_v1 = load8(ROW(Vp, k0, 32, rs_)); u_k0 = load8(ROW(Kp, k0, 0, rs_)); u_k1 = load8(ROW(Kp, k0, 32, rs_)); } while (0)
#define SWRITE_U(bf, off_) do { *(bf16x8*)(K_lds + (bf) * SHM_K + kws) = u_k0; *(bf16x8*)(K_lds + (bf) * SHM_K + kws + 32 * 256) = u_k1; \
        *(bf16x8*)(V_lds + (off_) + vst0) = u_v0; *(bf16x8*)(V_lds + (off_) + vst1) = u_v1; } while (0)
#define STAGE_BAR(t, BUF) do { \
        if ((t) + 1 < NT) { if ((t) + 2 < NT) asm volatile("s_waitcnt vmcnt(4)" ::: "memory"); else asm volatile("s_waitcnt vmcnt(0)" ::: "memory"); \
            if ((BUF) == 0) { SWRITE_U(1, vs_next); } else { SWRITE_HK(0); SWRITE_HV(vs_next); } } \
        asm volatile("s_waitcnt lgkmcnt(0)\n\ts_barrier" ::: "memory"); \
        if ((t) + 3 < NT) { if ((BUF) == 0) { SLOAD_U(Kh, Vh, KBASE((t) + 3), RS); } else { SLOAD_H(Kh, Vh, KBASE((t) + 3), RS); } } SBAR(); } while (0)
#define TILE(t, BUF) do { \
        const bool act_ = !SK || ACT(t); bf16x8 pa0, pa1, pa2, pa3; \
        if (act_) { f32x16 p0, p1; float mn, al; \
            qkt<BUF, false, MODE>(p0, p1, kba, r32, hi, qr, true, CSK(t), qx); \
            MASKT(p0, p1, t); partialSM(p0, p1, m_reg, mn, al); RESC(al); \
            finishSM(p0, p1, al, l_reg, pa0, pa1, pa2, pa3); SBAR(); } \
        if (grpB) STAGE_BAR(t, BUF); \
        if (act_) { pv_tile<0, false>(o, vb0 + vs_cur, pa0, pa1, pa2, pa3, true); SBAR(); } \
        if (!grpB) STAGE_BAR(t, BUF); \
        vs_cur = vs_next; vs_next = (vs_next == (NVS - 1) * SHM_V) ? 0 : vs_next + SHM_V; } while (0)
    if (NT > 1) { SLOAD_U(Kh, Vh, KBASE(1), RS); } SBAR();
    if (NT > 2) { SLOAD_H(Kh, Vh, KBASE(2), RS); } SBAR();
    for (int t = 0; t < NT; t += 2) { TILE(t, 0); TILE(t + 1, 1); }
#undef SLOAD_U
#undef SWRITE_U
#undef STAGE_BAR
    }
    {
        int tid2 = wave_u * 64 + fresh_lane(); asm volatile("" : "+v"(tid2));
        const int r32e = tid2 & 31, hie = (tid2 >> 5) & 1;
        if (hie == 0) li_l[r32e] = l_reg; asm volatile("s_waitcnt lgkmcnt(0)" ::: "memory");
        float rli[16];
#pragma unroll
        for (int r = 0; r < 16; ++r) rli[r] = __builtin_amdgcn_rcpf(li_l[crow(r, hie)]);
        char* Ow = (char*)(cur.O + (size_t)(cur.P0 + wid * QBLK) * rs);
        const unsigned ooff = (unsigned)(4 * hie * rs + r32e) * 2u;
#pragma unroll
        for (int r = 0; r < 16; ++r) { const unsigned orow = (unsigned)(((r & 3) + 8 * (r >> 2)) * rs) * 2u;
#pragma unroll
            for (int d0 = 0; d0 < 4; ++d0) { const float v = o[d0][r] * rli[r];
                const float vn = __builtin_bit_cast(float, __builtin_amdgcn_update_dpp(0, __builtin_bit_cast(int, v), 0xB1, 0xF, 0xF, false));
                if ((r32e & 1) == 0) *(unsigned*)(Ow + ooff + orow + d0 * 64) = cvtpk(v, vn); } }
        if constexpr (MODE == 2) { if (hie == 0) cur.L[(size_t)(cur.P0 + wid * QBLK + r32e) * (RS / 128)] = m_reg * SCALE + __logf(l_reg); }
    }
    __syncthreads();
#undef RESC
#undef KBASE
#undef ACT
#undef MASKT
#undef CSK
#undef TILE
}
#undef ROW
#undef VMW
#undef SLOAD_H
#undef SWRITE_HK
#undef SWRITE_HV
#undef SWRITE_H
#undef KSWZ
#undef KRD
#undef SB_ALU
#undef SBAR
}
namespace cg = cooperative_groups;
constexpr int NWAVES = 8;
constexpr int BATCH = 4, SEQ = 4096, DM = 2048, DEPTH = 2, NHF = 8, HD = 128, DH = 1024, NIN = 6152, DFF = 8192;
constexpr int M = BATCH * SEQ;
constexpr int NQKV = 6 * DH;
constexpr float NORM_EPS = 1e-6f;
constexpr size_t MiB = 1u << 20;
constexpr size_t WS_LF = 1 * MiB;
constexpr size_t WS_BT = 1 * MiB + 768 * 1024;
constexpr size_t WS_LSE = 2 * MiB;
constexpr size_t WS_KSQ = 3 * MiB + 512 * 1024;
constexpr size_t WS_WIN = 4 * MiB, WS_WOUT = 28 * MiB, WS_W1 = 36 * MiB, WS_W2 = 68 * MiB;
constexpr size_t WS_XN = 100 * MiB;
constexpr size_t WS_QKV = 164 * MiB;
constexpr size_t WS_OP = 356 * MiB;
constexpr size_t WS_YA = 452 * MiB;
constexpr size_t WS_H = 164 * MiB;
constexpr size_t WS_D1 = 420 * MiB;
constexpr size_t WS_END = 484 * MiB;
constexpr int LDS_BYTES = 147456;

#define GAS __attribute__((address_space(1)))
#define LAS __attribute__((address_space(3)))
typedef unsigned short bf16r;
typedef unsigned v4u __attribute__((ext_vector_type(4)));
typedef unsigned v2u __attribute__((ext_vector_type(2)));
typedef float f32x4 __attribute__((ext_vector_type(4)));
#define LDS_WAIT() asm volatile("s_waitcnt lgkmcnt(0)" ::: "memory")
__device__ __forceinline__ unsigned f2bf(float f) { unsigned u = __builtin_bit_cast(unsigned, f); return (u + 0x7fffu + ((u >> 16) & 1u)) >> 16; }
__device__ __forceinline__ unsigned pk2(float lo, float hi) { return f2bf(lo) | (f2bf(hi) << 16); }
__device__ __forceinline__ float bf2f(unsigned short h) { return __builtin_bit_cast(float, (unsigned)h << 16); }
__device__ __forceinline__ float wave_sum(float v, int lane) {
#pragma unroll
    for (int o = 1; o < 64; o <<= 1) v += __builtin_bit_cast(float, __builtin_amdgcn_ds_bpermute((lane ^ o) << 2, __builtin_bit_cast(int, v)));
    return v;
}

#define XB_TMO      128
#define XB_XCNT(j)  (256  + 64 * (j))
#define XB_XSUB(j)  (1280 + 64 * (j))
#define XB_XGEN(j)  (2304 + 64 * (j))
#define XB_TOP      3328
#define XB_TOPGEN   3392
#define XCD_BAR_WORDS 3456
#define XB_SPIN_CAP (1u << 18)

__device__ __forceinline__ unsigned xb_ld(unsigned* p)              { return __hip_atomic_load(p, __ATOMIC_RELAXED, __HIP_MEMORY_SCOPE_AGENT); }
__device__ __forceinline__ unsigned xb_add(unsigned* p, unsigned v) { return __hip_atomic_fetch_add(p, v, __ATOMIC_RELAXED, __HIP_MEMORY_SCOPE_AGENT); }
__device__ __forceinline__ unsigned xb_xcc_id() { return (unsigned)__builtin_amdgcn_s_getreg((3 << 11) | 20) & 0xFu; }
#define XB_SPIN(cond, bar) do { unsigned _sp = 0; while (cond) { __builtin_amdgcn_s_sleep(1); \
    if ((++_sp & 255u) == 0u) { if (xb_ld(&(bar)[XB_TMO])) break; if (_sp > XB_SPIN_CAP) { atomicAdd(&(bar)[XB_TMO], 1u); break; } } } } while (0)

struct XcdBarrier {
    unsigned* bar; unsigned x;
    volatile LAS unsigned* st;
};

__device__ __forceinline__ XcdBarrier xcd_barrier_post(unsigned* bar, volatile LAS unsigned* st) {
    XcdBarrier b; b.bar = bar; b.x = xb_xcc_id(); b.st = st;
    if (threadIdx.x == 0) (void)xb_add(&bar[XB_XCNT(b.x)], 1u);
    return b;
}
__device__ __forceinline__ void xcd_barrier_complete(unsigned* bar, unsigned x, unsigned& nloc, unsigned& nx) {
    const unsigned G = gridDim.x * gridDim.y * gridDim.z;
    unsigned sum, cnt, mine, sp = 0u;
    for (;;) {
        sum = 0u; cnt = 0u; mine = 0u;
#pragma unroll
        for (unsigned j = 0; j < 16; ++j) { const unsigned c = xb_ld(&bar[XB_XCNT(j)]); sum += c; cnt += (c > 0u) ? 1u : 0u; mine = (j == x) ? c : mine; }
        if (sum == G) break;
        __builtin_amdgcn_s_sleep(1);
        if ((++sp & 255u) == 0u) { if (xb_ld(&bar[XB_TMO])) break; if (sp > XB_SPIN_CAP) { atomicAdd(&bar[XB_TMO], 1u); break; } }
    }
    nloc = mine > 0u ? mine : 1u; nx = cnt > 0u ? cnt : 1u;
}

__device__ __forceinline__ void xcd_barrier(const XcdBarrier& b, const bool leader  ) {
    asm volatile("s_waitcnt vmcnt(0)" ::: "memory");
    __syncthreads();
    if (leader) {
        unsigned* bar = b.bar;
        __builtin_amdgcn_s_waitcnt(0);
        unsigned nloc = b.st[0], nx = b.st[1];
        if (nloc == 0u) { xcd_barrier_complete(bar, b.x, nloc, nx); b.st[0] = nloc; b.st[1] = nx; }
        const unsigned old = xb_add(&bar[XB_XSUB(b.x)], 1u);
        const unsigned gen = old / nloc;
        if (old + 1u == (gen + 1u) * nloc) {
            __builtin_amdgcn_fence(__ATOMIC_RELEASE, "agent");
            asm volatile("s_waitcnt vmcnt(0)" ::: "memory");
            const unsigned og = xb_add(&bar[XB_TOP], 1u);
            const unsigned tg = og / nx;
            if (og + 1u == (tg + 1u) * nx) xb_add(&bar[XB_TOPGEN], 1u);
            else XB_SPIN(xb_ld(&bar[XB_TOPGEN]) == tg, bar);
            __builtin_amdgcn_fence(__ATOMIC_ACQUIRE, "agent");
            xb_add(&bar[XB_XGEN(b.x)], 1u);
            asm volatile("s_waitcnt vmcnt(0)" ::: "memory");
        } else {
            XB_SPIN(xb_ld(&bar[XB_XGEN(b.x)]) == gen, bar);
            __builtin_amdgcn_fence(__ATOMIC_ACQUIRE, "agent");
            asm volatile("s_waitcnt vmcnt(0)" ::: "memory");
        }
    }
    __syncthreads();
}

__device__ __forceinline__ f32x4 add_bf4(f32x4 v, v2u d) {
    v.x += __builtin_bit_cast(float, d.x << 16); v.y += __builtin_bit_cast(float, d.x & 0xffff0000u);
    v.z += __builtin_bit_cast(float, d.y << 16); v.w += __builtin_bit_cast(float, d.y & 0xffff0000u); return v; }
struct Args { const float* in[12]; float* out; unsigned char* ws; };

__device__ __forceinline__ void transpose_item(const float* W, int K, int ldw, int c0, int N, bf16r* WT, int row_off, LAS float* scr, int item, int lane) {
    const int nblk = N / 32, kb = item / nblk, nb = item % nblk, k0 = 64 * kb, n0 = 32 * nb;
#pragma unroll 8
    for (int i = 0; i < 32; ++i) { const int kk = 2 * i + (lane >> 5); scr[kk * 33 + (lane & 31)] = W[(size_t)(k0 + kk) * ldw + c0 + n0 + (lane & 31)]; }
    LDS_WAIT(); asm volatile("" ::: "memory");
    const int c = lane & 7;
#pragma unroll
    for (int j = 0; j < 4; ++j) { const int n = (lane >> 3) + 8 * j; const LAS float* s = scr + (8 * c) * 33 + n;
        v4u o; o.x = pk2(s[0 * 33], s[1 * 33]); o.y = pk2(s[2 * 33], s[3 * 33]); o.z = pk2(s[4 * 33], s[5 * 33]); o.w = pk2(s[6 * 33], s[7 * 33]);
        *(v4u*)(WT + (size_t)(row_off + n0 + n) * K + k0 + 8 * c) = o; }
    LDS_WAIT(); asm volatile("" ::: "memory");
}

__device__ __forceinline__ int t5_bucket(int dist) {
    if (dist < 16) return dist;
    const int thr[15] = {22, 30, 40, 54, 73, 99, 134, 182, 246, 332, 450, 609, 825, 1117, 1513};
    int b = 16;
#pragma unroll
    for (int i = 0; i < 15; ++i) b += (dist >= thr[i]) ? 1 : 0;
    return b;
}

#ifndef GEMM_WGM
#define GEMM_WGM 4
#endif
#ifndef STAGGER_US
#define STAGGER_US 0
#endif
__device__ __forceinline__ void stagger_start(int bx) {
    const unsigned long long ticks = (unsigned long long)(((bx >> 3) & 3) * STAGGER_US * 100);
    const unsigned long long t0 = __builtin_amdgcn_s_memrealtime();
    while (__builtin_amdgcn_s_memrealtime() - t0 < ticks) __builtin_amdgcn_s_sleep(4);
}
#define PHASE_PTRS() \
    const __attribute__((address_space(4))) Args* ap_ = (const __attribute__((address_space(4))) Args*)__builtin_amdgcn_kernarg_segment_ptr(); asm volatile("" : "+s"(ap_)); \
    unsigned char* const ws = ap_->ws; (void)ws; \
    const float* const x_in = ap_->in[0]; const float* const norm1_g = ap_->in[1]; const float* const w_in = ap_->in[2]; const float* const forget_b = ap_->in[3]; \
    const float* const rel_bias = ap_->in[4]; const float* const ona_g = ap_->in[5]; const float* const onb_g = ap_->in[6]; const float* const w_out = ap_->in[7]; \
    const float* const norm2_g = ap_->in[8]; const float* const w_mlp_in = ap_->in[9]; const float* const w_mlp_out = ap_->in[10]; const float* const final_g = ap_->in[11]; \
    float* const XR = ap_->out; \
    float* const KSQ = (float*)(ws + WS_KSQ); (void)KSQ; \
    float* const LF = (float*)(ws + WS_LF); float* const BT = (float*)(ws + WS_BT); float* const LSE = (float*)(ws + WS_LSE); \
    bf16r* const Win_t = (bf16r*)(ws + WS_WIN); bf16r* const Wout_t = (bf16r*)(ws + WS_WOUT); bf16r* const W1_t = (bf16r*)(ws + WS_W1); bf16r* const W2_t = (bf16r*)(ws + WS_W2); \
    bf16r* const XN = (bf16r*)(ws + WS_XN); bf16r* const QKV = (bf16r*)(ws + WS_QKV); bf16r* const OP = (bf16r*)(ws + WS_OP); bf16r* const YA = (bf16r*)(ws + WS_YA); \
    bf16r* const HB = (bf16r*)(ws + WS_H); bf16r* const D1 = (bf16r*)(ws + WS_D1); \
    (void)x_in; (void)norm1_g; (void)w_in; (void)forget_b; (void)rel_bias; (void)ona_g; (void)onb_g; (void)w_out; (void)norm2_g; (void)w_mlp_in; (void)w_mlp_out; (void)final_g; (void)XR; \
    (void)LF; (void)BT; (void)LSE; (void)Win_t; (void)Wout_t; (void)W1_t; (void)W2_t; (void)XN; (void)QKV; (void)OP; (void)YA; (void)HB; (void)D1
__global__ void __launch_bounds__(NWAVES * 64, 2) hymba_fwd(Args args) {
    extern __shared__ __attribute__((aligned(16))) unsigned char lds[];
    cg::grid_group grid = cg::this_grid();
    const int wave_u = __builtin_amdgcn_readfirstlane((int)threadIdx.x >> 6);
    volatile LAS unsigned* bst = (volatile LAS unsigned*)((LAS unsigned char*)lds + 131072);
    if (threadIdx.x < 2) bst[threadIdx.x] = 0u;
    __syncthreads();
    if (args.ws == nullptr) grid.sync();
    const XcdBarrier xbar = xcd_barrier_post((unsigned*)args.ws, bst);
    const int G = gridDim.x, bx = blockIdx.x;
    const int vcu = (G % 8 == 0) ? (bx % 8) * (G / 8) + bx / 8 : bx;
    const int NGW = G * NWAVES;
#ifdef DIAG
#define STAMP(k) do { if (blockIdx.x == 0 && threadIdx.x == 0) ((unsigned long long*)(args.ws + 512 * 1024))[(k)] = __builtin_amdgcn_s_memrealtime(); } while (0)
#else
#define STAMP(k) do {} while (0)
#endif
#define PHASE_IDS() int tid = wave_u * 64 + fresh_lane(); asm volatile("" : "+v"(tid)); const int lane = tid & 63, wave = wave_u, gw = vcu * NWAVES + wave; (void)lane; (void)gw
    constexpr size_t QSTR = (size_t)M * DH;

    { PHASE_IDS(); PHASE_PTRS();
    for (int i = gw * 64 + lane; i < 3 * 8 * swa::TABN; i += NGW * 64) {
        const int e = i % swa::TABN, h = (i / swa::TABN) % 8, p = i / (swa::TABN * 8), rel = e - swa::TABOFF, dil = (p == 0) ? 1 : (p == 1) ? 4 : 16;
        BT[i] = (rel >= 0 && rel <= 128) ? rel_bias[t5_bucket(rel * dil) * 8 + h] * (1.f / swa::SCALE) : 0.f;
    }
    }

    STAMP(0);
#pragma unroll 1
    for (int l = 0; l < DEPTH; ++l) {
#if PHASES & 1
        for (int rep_ = 0; rep_ < REP0; ++rep_) {
            PHASE_IDS(); PHASE_PTRS();
            LAS float* scr = (LAS float*)(lds) + wave * 4096;
            const float* Wi = w_in + (size_t)l * DM * NIN; const float* Wo = w_out + (size_t)l * DM * DM;
            const float* Wa = w_mlp_in + (size_t)l * DM * DFF; const float* Wb = w_mlp_out + (size_t)l * DFF * DM;
            constexpr int I_S = (DM / 64) * (DH / 32), I_O = (DM / 64) * (DM / 32), I_1 = (DM / 64) * (DFF / 32), I_2 = (DFF / 64) * (DM / 32);
            constexpr int NITEMS = 6 * I_S + I_O + I_1 + I_2;
            for (int it = gw; it < NITEMS; it += NGW) {
                int r = it;
                if (r < 6 * I_S) { const int s = r / I_S; const int c0 = s * DH + (s >= 3 ? 8 : 0); transpose_item(Wi, DM, NIN, c0, DH, Win_t, s * DH, scr, r % I_S, lane); continue; } r -= 6 * I_S;
                if (r < I_O) { transpose_item(Wo, DM, DM, 0, DM, Wout_t, 0, scr, r, lane); continue; } r -= I_O;
                if (r < I_1) { transpose_item(Wa, DM, DFF, 0, DFF, W1_t, 0, scr, r, lane); continue; } r -= I_1;
                transpose_item(Wb, DFF, DM, 0, DM, W2_t, 0, scr, r, lane);
            }
            __syncthreads();
            LAS f32x4* wf = (LAS f32x4*)lds;
            const float* g1 = norm1_g + (size_t)l * DM;
            for (int k = tid; k < DM; k += NWAVES * 64) {
                const float gk = g1[k]; const float* src = Wi + (size_t)k * NIN + 3 * DH;
                const f32x4 a = *(const f32x4*)src, b = *(const f32x4*)(src + 4);
                const int j = k >> 8, ln = (k & 255) >> 2, e = k & 3;
                wf[((j * 4 + e) * 2 + 0) * 64 + ln] = a * gk; wf[((j * 4 + e) * 2 + 1) * 64 + ln] = b * gk;
            }
            __syncthreads();
            const float* fb = forget_b + l * NHF;
            for (int m = gw; m < M; m += NGW) {
                const float* xprev = (l == 0) ? x_in : ((l == 1) ? x_in : XR);
                const f32x4* xr = (const f32x4*)(xprev + (size_t)m * DM) + lane;
                f32x4 v[8]; float ss = 0.f;
#pragma unroll
                for (int j = 0; j < 8; ++j) v[j] = xr[64 * j];
                if (l > 0) {
                    const v2u* dr = (const v2u*)(XN + (size_t)m * DM) + lane; const v2u* er = (const v2u*)(D1 + (size_t)m * DM) + lane; v2u d[8], e[8];
#pragma unroll
                    for (int j = 0; j < 8; ++j) { d[j] = dr[64 * j]; e[j] = er[64 * j]; }
                    f32x4* xw = (f32x4*)(XR + (size_t)m * DM) + lane;
#pragma unroll
                    for (int j = 0; j < 8; ++j) { v[j] = add_bf4(add_bf4(v[j], e[j]), d[j]); xw[64 * j] = v[j]; }
                }
#pragma unroll
                for (int j = 0; j < 8; ++j) ss += (v[j].x * v[j].x + v[j].y * v[j].y) + (v[j].z * v[j].z + v[j].w * v[j].w);
                f32x4 fa = {0.f, 0.f, 0.f, 0.f}, fbv = {0.f, 0.f, 0.f, 0.f};
#pragma unroll
                for (int j = 0; j < 8; ++j) {
#pragma unroll
                    for (int e = 0; e < 4; ++e) { const float xv = v[j][e]; fa += wf[((j * 4 + e) * 2 + 0) * 64 + lane] * xv; fbv += wf[((j * 4 + e) * 2 + 1) * 64 + lane] * xv; }
                    asm volatile("" ::: "memory"); }
                const float rstd = 1.f / sqrtf(wave_sum(ss, lane) * (1.f / DM) + NORM_EPS);
                float f8[8];
#pragma unroll
                for (int e = 0; e < 4; ++e) { f8[e] = wave_sum(fa[e], lane); f8[4 + e] = wave_sum(fbv[e], lane); }
                float fsel = f8[0];
#pragma unroll
                for (int e = 1; e < 8; ++e) fsel = (lane == e) ? f8[e] : fsel;
                if (lane < 8) { const float z = fsel * rstd + fb[lane]; const float ls = fminf(z, 0.f) - __logf(1.f + __expf(-fabsf(z)));
                    LF[((size_t)(m / SEQ) * NHF + lane) * SEQ + (m % SEQ)] = ls; KSQ[((size_t)(m / SEQ) * NHF + lane) * SEQ + (m % SEQ)] = 0.f; }
                const f32x4* gr = (const f32x4*)g1 + lane;
                v2u* o8 = (v2u*)(XN + (size_t)m * DM) + lane;
#pragma unroll
                for (int j = 0; j < 8; ++j) { const f32x4 g = gr[64 * j]; v2u w; w.x = pk2(v[j].x * rstd * g.x, v[j].y * rstd * g.y); w.y = pk2(v[j].z * rstd * g.z, v[j].w * rstd * g.w); o8[64 * j] = w; }
            }
        }
#endif
        xcd_barrier(xbar, wave_u == 0 && fresh_lane() == 0); STAMP(1 + l * 8 + 0);
#if REPSYNC > 1
        for (int rs_ = 0; rs_ < 8; ++rs_) xcd_barrier(xbar, wave_u == 0 && fresh_lane() == 0);
#endif
#if PHASES & 2
        for (int rep_ = 0; rep_ < REP1; ++rep_) {
            PHASE_PTRS();
            pg8::Gemm g{XN, Win_t, M, NQKV, DM}; pg8::StaticOrder S; S.init(M, NQKV, G, bx, GEMM_WGM);
            pg8::EpiQKVn E{QKV, DH, QSTR, KSQ, SEQ};
            pg8::gemm_phase<pg8::EpiQKVn, pg8::StaticOrder, true, true>((LAS unsigned char*)lds, g, S, E, wave_u);
        }
#endif
        xcd_barrier(xbar, wave_u == 0 && fresh_lane() == 0); STAMP(1 + l * 8 + 1);
        {
            PHASE_PTRS();
            const swa::bf16* Qa = (const swa::bf16*)QKV; const swa::bf16* Ka = Qa + QSTR; const swa::bf16* Va = Qa + 2 * QSTR;
            const swa::bf16* Qb = Qa + 3 * QSTR; const swa::bf16* Kb = Qa + 4 * QSTR; const swa::bf16* Vb = Qa + 5 * QSTR;
#if PHASES & 4
            for (int rep_ = 0; rep_ < REP2A; ++rep_) {
                const int nitems = (vcu < 256) ? (255 - vcu) / G + 1 : 0, nblk = 2 * nitems;
                auto ref = [&](int k) { const int item = vcu + (k >> 1) * G, bh = item >> 3, y = item & 7, qb = (k & 1) ? 15 - y : y, b = bh >> 3, h = bh & 7;
                    const size_t off = (size_t)b * SEQ * DH + h * HD;
                    swa::BlockRef r; r.Q = Qa + off; r.K = Ka + off; r.V = Va + off; r.O = (swa::bf16*)YA + off; r.L = nullptr; r.aux = LF + (size_t)bh * SEQ; r.aux2 = KSQ + (size_t)bh * SEQ;
                    r.P0 = qb * 256; r.skv = SEQ; r.W = 1 << 30; r.pad = 0; return r; };
                for (int k = 0; k < nblk; ++k) { const swa::BlockRef cur = ref(k); swa::swa_block<1, true, DH>(cur, (char*)lds, wave_u); }
            }
#endif
#if PHASES & 8
#define DIL_STREAM(P_, DIL_) do { constexpr int NB = 512; const int per = (NB + G - 1) / G, first = vcu * per, last = (first + per < NB) ? first + per : NB; \
                auto ref = [&](int g) { const int bh = (g >> 4) & 31, j = g & 15, b = bh >> 3, h = bh & 7; constexpr int nbr = 16 / DIL_; const int res = j / nbr, blk = j % nbr; \
                    const size_t off = ((size_t)b * SEQ + res) * DH + h * HD; \
                    swa::BlockRef r; r.Q = Qb + off; r.K = Kb + off; r.V = Vb + off; r.O = (swa::bf16*)OP + (size_t)P_ * QSTR + off; \
                    r.L = LSE + ((size_t)P_ * M + (size_t)b * SEQ + res) * 8 + h; r.aux = BT + (size_t)(P_ * 8 + h) * swa::TABN; r.aux2 = nullptr; \
                    r.P0 = blk * 256; r.skv = SEQ / DIL_; r.W = 129; r.pad = 0; return r; }; \
                for (int g = first; g < last; ++g) { const swa::BlockRef cur = ref(g); swa::swa_block<2, true, DH * DIL_>(cur, (char*)lds, wave_u); } } while (0)
            for (int rep_ = 0; rep_ < REP2B; ++rep_) { DIL_STREAM(0, 1); DIL_STREAM(1, 4); DIL_STREAM(2, 16); }
#undef DIL_STREAM
#endif
        }
        xcd_barrier(xbar, wave_u == 0 && fresh_lane() == 0); STAMP(1 + l * 8 + 2);
#if PHASES & 16
        for (int rep_ = 0; rep_ < REP3; ++rep_) {
            PHASE_IDS(); PHASE_PTRS();
            const float* ga = ona_g + (size_t)l * DH; const float* gb = onb_g + (size_t)l * DH;
            for (int m = gw; m < M; m += NGW) {
                const int h = lane >> 3;
                const float l0 = LSE[((size_t)0 * M + m) * 8 + h], l1 = LSE[((size_t)1 * M + m) * 8 + h], l2 = LSE[((size_t)2 * M + m) * 8 + h];
                const float mx = fmaxf(l0, fmaxf(l1, l2)); float a0 = __expf(l0 - mx), a1 = __expf(l1 - mx), a2 = __expf(l2 - mx);
                const float inv = 1.f / (a0 + a1 + a2); a0 *= inv; a1 *= inv; a2 *= inv;
                const v4u* ya = (const v4u*)(YA + (size_t)m * DH) + 2 * lane;
                const v4u* o0 = (const v4u*)(OP + (size_t)m * DH) + 2 * lane; const v4u* o1 = (const v4u*)(OP + QSTR + (size_t)m * DH) + 2 * lane; const v4u* o2 = (const v4u*)(OP + 2 * QSTR + (size_t)m * DH) + 2 * lane;
                float va[16], vb[16]; float sa = 0.f, sb = 0.f;
#pragma unroll
                for (int q = 0; q < 2; ++q) { const v4u ua = ya[q], u0 = o0[q], u1 = o1[q], u2 = o2[q];
#pragma unroll
                    for (int e = 0; e < 4; ++e) {
                        const float alo = __builtin_bit_cast(float, ua[e] << 16), ahi = __builtin_bit_cast(float, ua[e] & 0xffff0000u);
                        const float blo = a0 * __builtin_bit_cast(float, u0[e] << 16) + a1 * __builtin_bit_cast(float, u1[e] << 16) + a2 * __builtin_bit_cast(float, u2[e] << 16);
                        const float bhi = a0 * __builtin_bit_cast(float, u0[e] & 0xffff0000u) + a1 * __builtin_bit_cast(float, u1[e] & 0xffff0000u) + a2 * __builtin_bit_cast(float, u2[e] & 0xffff0000u);
                        va[q * 8 + 2 * e] = alo; va[q * 8 + 2 * e + 1] = ahi; vb[q * 8 + 2 * e] = blo; vb[q * 8 + 2 * e + 1] = bhi;
                        sa += alo * alo + ahi * ahi; sb += blo * blo + bhi * bhi; } }
                const float ra = 1.f / sqrtf(wave_sum(sa, lane) * (1.f / DH) + NORM_EPS), rb = 1.f / sqrtf(wave_sum(sb, lane) * (1.f / DH) + NORM_EPS);
                const f32x4* gar = (const f32x4*)ga + 4 * lane; const f32x4* gbr = (const f32x4*)gb + 4 * lane;
                v4u* oa = (v4u*)(XN + (size_t)m * DM) + 2 * lane; v4u* ob = (v4u*)(XN + (size_t)m * DM + DH) + 2 * lane;
#pragma unroll
                for (int q = 0; q < 2; ++q) { const f32x4 g0 = gar[2 * q], g1 = gar[2 * q + 1], h0 = gbr[2 * q], h1 = gbr[2 * q + 1];
                    v4u wa, wb;
                    wa.x = pk2(va[q * 8 + 0] * ra * g0.x, va[q * 8 + 1] * ra * g0.y); wa.y = pk2(va[q * 8 + 2] * ra * g0.z, va[q * 8 + 3] * ra * g0.w);
                    wa.z = pk2(va[q * 8 + 4] * ra * g1.x, va[q * 8 + 5] * ra * g1.y); wa.w = pk2(va[q * 8 + 6] * ra * g1.z, va[q * 8 + 7] * ra * g1.w);
                    wb.x = pk2(vb[q * 8 + 0] * rb * h0.x, vb[q * 8 + 1] * rb * h0.y); wb.y = pk2(vb[q * 8 + 2] * rb * h0.z, vb[q * 8 + 3] * rb * h0.w);
                    wb.z = pk2(vb[q * 8 + 4] * rb * h1.x, vb[q * 8 + 5] * rb * h1.y); wb.w = pk2(vb[q * 8 + 6] * rb * h1.z, vb[q * 8 + 7] * rb * h1.w);
                    oa[q] = wa; ob[q] = wb; }
            }
        }
#endif
        xcd_barrier(xbar, wave_u == 0 && fresh_lane() == 0); STAMP(1 + l * 8 + 3);
#if PHASES & 32
        {
            PHASE_PTRS();
            pg8::Gemm g{XN, Wout_t, M, DM, DM}; pg8::StaticOrder S; S.init(M, DM, G, bx, GEMM_WGM);
#if REP4 > 1
            { pg8::EpiNull EN; pg8::gemm_phase<pg8::EpiNull, pg8::StaticOrder, true, true>((LAS unsigned char*)lds, g, S, EN, wave_u); }
#endif
            pg8::EpiBf16<0> E{D1, DM, nullptr, 0, 0, 1.f};
            pg8::gemm_phase<pg8::EpiBf16<0>, pg8::StaticOrder, true, true>((LAS unsigned char*)lds, g, S, E, wave_u);
        }
#endif
        xcd_barrier(xbar, wave_u == 0 && fresh_lane() == 0); STAMP(1 + l * 8 + 4);
#if PHASES & 64
        for (int rep_ = 0; rep_ < REP5; ++rep_) {
            PHASE_IDS(); PHASE_PTRS(); const float* xsrc = (l == 0) ? x_in : XR;
            const float* g2 = norm2_g + (size_t)l * DM;
            for (int m = gw; m < M; m += NGW) {
                const f32x4* xr = (const f32x4*)(xsrc + (size_t)m * DM) + lane;
                const v2u* dr = (const v2u*)(D1 + (size_t)m * DM) + lane;
                f32x4 v[8]; v2u d[8]; float ss = 0.f;
#pragma unroll
                for (int j = 0; j < 8; ++j) { v[j] = xr[64 * j]; d[j] = dr[64 * j]; }
#pragma unroll
                for (int j = 0; j < 8; ++j) { v[j] = add_bf4(v[j], d[j]); ss += (v[j].x * v[j].x + v[j].y * v[j].y) + (v[j].z * v[j].z + v[j].w * v[j].w); }
                const float rstd = 1.f / sqrtf(wave_sum(ss, lane) * (1.f / DM) + NORM_EPS);
                const f32x4* gr = (const f32x4*)g2 + lane;
                v2u* o8 = (v2u*)(XN + (size_t)m * DM) + lane;
#pragma unroll
                for (int j = 0; j < 8; ++j) { const f32x4 g = gr[64 * j]; v2u w; w.x = pk2(v[j].x * rstd * g.x, v[j].y * rstd * g.y); w.y = pk2(v[j].z * rstd * g.z, v[j].w * rstd * g.w); o8[64 * j] = w; }
            }
        }
#endif
        xcd_barrier(xbar, wave_u == 0 && fresh_lane() == 0); STAMP(1 + l * 8 + 5);
#if PHASES & 128
        for (int rep_ = 0; rep_ < REP6; ++rep_) {
            PHASE_PTRS();
            pg8::Gemm g{XN, W1_t, M, DFF, DM}; pg8::StaticOrder S; S.init(M, DFF, G, bx, GEMM_WGM);
#if REP6N > 1
            { pg8::EpiNull EN; pg8::gemm_phase<pg8::EpiNull, pg8::StaticOrder, true, true>((LAS unsigned char*)lds, g, S, EN, wave_u); }
#endif
            pg8::EpiBf16<2> E{HB, DFF, nullptr, 0, 0, 1.f};
            pg8::gemm_phase<pg8::EpiBf16<2>, pg8::StaticOrder, true, true>((LAS unsigned char*)lds, g, S, E, wave_u);
        }
#endif
        xcd_barrier(xbar, wave_u == 0 && fresh_lane() == 0); STAMP(1 + l * 8 + 6);
#if PHASES & 256
        {
            PHASE_PTRS();
            pg8::Gemm g{HB, W2_t, M, DM, DFF}; pg8::StaticOrder S; S.init(M, DM, G, bx, GEMM_WGM);
#if REP7 == 2
            { pg8::EpiNull EN; pg8::gemm_phase<pg8::EpiNull, pg8::StaticOrder, true, true>((LAS unsigned char*)lds, g, S, EN, wave_u); }
#endif
            pg8::EpiBf16<0> E{XN, DM, nullptr, 0, 0, 1.f};
            pg8::gemm_phase<pg8::EpiBf16<0>, pg8::StaticOrder, true, true>((LAS unsigned char*)lds, g, S, E, wave_u);
        }
#endif
        xcd_barrier(xbar, wave_u == 0 && fresh_lane() == 0); STAMP(1 + l * 8 + 7);
    }
    { PHASE_IDS(); PHASE_PTRS();
    for (int m = gw; m < M; m += NGW) {
        f32x4* xr = (f32x4*)(XR + (size_t)m * DM) + lane;
        const v2u* dr = (const v2u*)(XN + (size_t)m * DM) + lane; const v2u* er = (const v2u*)(D1 + (size_t)m * DM) + lane;
        f32x4 v[8]; v2u d[8], e[8]; float ss = 0.f;
#pragma unroll
        for (int j = 0; j < 8; ++j) { v[j] = xr[64 * j]; d[j] = dr[64 * j]; e[j] = er[64 * j]; }
#pragma unroll
        for (int j = 0; j < 8; ++j) { v[j] = add_bf4(add_bf4(v[j], e[j]), d[j]); ss += (v[j].x * v[j].x + v[j].y * v[j].y) + (v[j].z * v[j].z + v[j].w * v[j].w); }
        const float rstd = 1.f / sqrtf(wave_sum(ss, lane) * (1.f / DM) + NORM_EPS);
        const f32x4* gr = (const f32x4*)final_g + lane;
#pragma unroll
        for (int j = 0; j < 8; ++j) xr[64 * j] = v[j] * rstd * gr[64 * j];
    }
    }
#ifdef DIAG
    grid.sync(); STAMP(17);
    if (blockIdx.x == 0 && threadIdx.x < 64) {
        __threadfence();
        const float t1 = (float)(TS[DIAG_B1] - TS[DIAG_A1]) * 0.01f, t2 = (float)(TS[DIAG_B2] - TS[DIAG_A2]) * 0.01f;
        if (threadIdx.x == 0) XR[0] = t1;
        for (int i = threadIdx.x; i < 4096; i += 64) XR[64 + i] = t2;
    }
#endif
}

extern "C" void kernel_launch(void* const* d_in, const int* in_sizes, int n_in, void* d_out, int out_size, void* d_ws, size_t ws_size, hipStream_t stream) {
    static int grid = 0;
    if (grid == 0) {
        if (n_in != 12 || out_size != M * DM || ws_size < WS_END) { fprintf(stderr, "kernel_launch: unexpected shapes (n_in %d out %d ws %zu)\n", n_in, out_size, ws_size); grid = -1; return; }
        int dev = 0, cus = 0, per_cu = 0;
        (void)hipGetDevice(&dev); (void)hipDeviceGetAttribute(&cus, hipDeviceAttributeMultiprocessorCount, dev);
        if (hipFuncSetAttribute((const void*)hymba_fwd, hipFuncAttributeMaxDynamicSharedMemorySize, LDS_BYTES) != hipSuccess) { fprintf(stderr, "kernel_launch: hipFuncSetAttribute failed\n"); grid = -1; return; }
        if (hipOccupancyMaxActiveBlocksPerMultiprocessor(&per_cu, (const void*)hymba_fwd, NWAVES * 64, LDS_BYTES) != hipSuccess || per_cu < 1) { fprintf(stderr, "kernel_launch: occupancy query gives %d\n", per_cu); per_cu = 1; }
        (void)hipGetLastError();
        grid = cus * 1;
        if (grid <= 0) grid = 256;
    }
    if (grid < 0) return;
    if (hipMemsetAsync(d_ws, 0, 16384, stream) != hipSuccess) { fprintf(stderr, "kernel_launch: hipMemsetAsync failed\n"); return; }
    Args a{};
    for (int i = 0; i < 12; ++i) a.in[i] = (const float*)d_in[i];
    a.out = (float*)d_out; a.ws = (unsigned char*)d_ws;
    void* kargs[] = {&a};
    hipError_t e = hipLaunchCooperativeKernel((const void*)hymba_fwd, dim3(grid), dim3(NWAVES * 64), kargs, LDS_BYTES, stream);
    if (e != hipSuccess) fprintf(stderr, "kernel_launch: cooperative launch failed: %s (grid %d)\n", hipGetErrorString(e), grid);
}
```

```cpp
#include <hip/hip_runtime.h>
#include <hip/hip_cooperative_groups.h>
#include <hip/hip_bf16.h>
#include <cstdio>
#include <cstdint>
#include <cmath>
#ifndef PHASES
#define PHASES 511
#endif
#ifndef REP0
#define REP0 1
#endif
#ifndef REP1
#define REP1 1
#endif
#ifndef REP2A
#define REP2A 1
#endif
#ifndef REP2B
#define REP2B 1
#endif
#ifndef REP3
#define REP3 1
#endif
#ifndef REP5
#define REP5 1
#endif
#ifndef REP6
#define REP6 1
#endif
#ifndef REP7
#define REP7 1
#endif
#ifndef REP4
#define REP4 1
#endif
#ifndef REPSYNC
#define REPSYNC 1
#endif
#ifndef REP6N
#define REP6N 1
#endif
__device__ __forceinline__ int fresh_lane() { unsigned z = 0u; asm volatile("" : "+s"(z)); return (int)__builtin_amdgcn_mbcnt_hi(~0u, __builtin_amdgcn_mbcnt_lo(~0u, z)); }
namespace pg8 {
#define PG8_LAS __attribute__((address_space(3)))
typedef unsigned short bf16_t;
typedef short bf16x8 __attribute__((ext_vector_type(8)));
typedef float f32x4 __attribute__((ext_vector_type(4)));
typedef unsigned u32x4 __attribute__((ext_vector_type(4)));
constexpr int BM = 256, BK = 64, HALF = 128, HTB = HALF * BK * 2  , STAGE_BYTES = 8 * HTB, NXCD = 8, WGM = 8;

__host__ __device__ __forceinline__ int lds_byte(int r, int c) { const int st = (r >> 4) * 2 + (c >> 5), rr = r & 15, cc = c & 31, ob = rr * 64 + cc * 2; return st * 1024 + (ob ^ (((ob >> 9) & 1) << 5)); }
__host__ __device__ __forceinline__ void stage_rc(int b, int& R, int& C) { const int st = b / 1024, sb = b % 1024, swz = sb ^ (((sb >> 9) & 1) << 5); R = (st >> 1) * 16 + swz / 64; C = (st & 1) * 32 + (swz % 64) / 2; }
__host__ __device__ __forceinline__ int perm32(int rho) { const int n = rho >> 4, i = rho & 15; return 8 * (i >> 2) + 4 * n + (i & 3); }

struct Unit { int pm, pn; };
struct Gemm { const bf16_t* A; const bf16_t* Bt; int M, N, K; };

struct StaticOrder {
    int nM, nN, nwg, G, c, wgm;
    __host__ __device__ void init(int M, int N, int G_, int c_, int wgm_ = WGM) { nM = M / BM; nN = N / BM; nwg = nM * nN; G = G_; c = c_; wgm = wgm_; }
    __host__ __device__ bool next(int i, Unit& u) const {
        const long L = (long)i * G + c; if (L >= nwg) return false;
        int wgid = (int)L; { const int q = nwg / NXCD, r = nwg % NXCD, xcd = wgid % NXCD, off = wgid / NXCD; wgid = (xcd < r ? xcd * (q + 1) : r * (q + 1) + (xcd - r) * q) + off; }
        const int nig = wgm * nN, gid = wgid / nig, fm = gid * wgm, gsz = (nM - fm) < wgm ? (nM - fm) : wgm;
        u.pm = fm + ((wgid % nig) % gsz); u.pn = (wgid % nig) / gsz; return true;
    }
    __device__ __forceinline__ void a_ready(const Unit&) const {}
    __device__ __forceinline__ void done(const Unit&) const {}
};

__device__ __forceinline__ unsigned cvt_pk_bf16(float lo, float hi) { unsigned r; asm volatile("v_cvt_pk_bf16_f32 %0, %1, %2" : "=v"(r) : "v"(lo), "v"(hi)); return r; }
typedef float f32x2 __attribute__((ext_vector_type(2)));
__device__ __forceinline__ f32x2 gelu_pk(f32x2 v) {
    const f32x2 av = __builtin_elementwise_abs(v), d = av * 0.2316418882f + 1.0f;
    f32x2 t; t.x = __builtin_amdgcn_rcpf(d.x); t.y = __builtin_amdgcn_rcpf(d.y);
    f32x2 q = t * 0.5307027145f + (-0.7265760135f); q = q * t + 0.7107068705f; q = q * t + (-0.142248368f); q = q * t + 0.127414796f; q = q * t;
    const f32x2 s = (v * v) * (-0.72134752044f);
    f32x2 e; e.x = __builtin_amdgcn_exp2f(s.x); e.y = __builtin_amdgcn_exp2f(s.y);
    const f32x2 m = v * (q * e), r = v - m;
    f32x2 o; o.x = v.x < 0.f ? m.x : r.x; o.y = v.y < 0.f ? m.y : r.y; return o;
}

template <int ACT  > struct EpiBf16 {
    static constexpr bool PERM = true, AFTER_DRAIN = false; static_assert(ACT == 0 || ACT == 1 || ACT == 2, "EpiBf16: ACT is 0 (none), 1 (gelu_pk) or 2 (squared relu)");
    bf16_t* O; int ldc; const float* bias; int split_cols; size_t split_stride; float scale0;
    __device__ __forceinline__ void operator()(const f32x4 (&acc)[2][2][4][2], const Unit& u, int wr, int wc, int fr, int fq) const {
        const int row0 = u.pm * BM + wr * 64 + fr; int colt = u.pn * BM; bf16_t* base = O;
        float sc = 1.f; if (split_cols) { const int t = colt / split_cols; base += (size_t)t * split_stride; colt -= t * split_cols; if (t == 0) sc = scale0; }
        const int col0 = colt + wc * 32 + 8 * fq, bcol0 = u.pn * BM + wc * 32 + 8 * fq;
        f32x4 bv[2][2];
#pragma unroll
        for (int bj = 0; bj < 2; ++bj)
#pragma unroll
            for (int n = 0; n < 2; ++n) bv[bj][n] = bias ? *(const f32x4*)(bias + bcol0 + bj * HALF + 4 * n) : (f32x4){0.f, 0.f, 0.f, 0.f};
#pragma unroll
        for (int ai = 0; ai < 2; ++ai)
#pragma unroll
            for (int m = 0; m < 4; ++m) { bf16_t* rowp = base + (size_t)(row0 + ai * HALF + m * 16) * ldc + col0;
#pragma unroll
                for (int bj = 0; bj < 2; ++bj) { f32x4 v0 = acc[ai][bj][m][0] + bv[bj][0], v1 = acc[ai][bj][m][1] + bv[bj][1];
                    if (ACT == 1) { f32x2 a = gelu_pk((f32x2){v0[0], v0[1]}), b = gelu_pk((f32x2){v0[2], v0[3]}), c = gelu_pk((f32x2){v1[0], v1[1]}), d = gelu_pk((f32x2){v1[2], v1[3]});
                        v0 = (f32x4){a.x, a.y, b.x, b.y}; v1 = (f32x4){c.x, c.y, d.x, d.y}; }
                    if (ACT == 2) { v0 = __builtin_elementwise_max(v0, (f32x4){0.f, 0.f, 0.f, 0.f}); v1 = __builtin_elementwise_max(v1, (f32x4){0.f, 0.f, 0.f, 0.f}); v0 = v0 * v0; v1 = v1 * v1; }
                    v0 = v0 * sc; v1 = v1 * sc; u32x4 w; w.x = cvt_pk_bf16(v0[0], v0[1]); w.y = cvt_pk_bf16(v0[2], v0[3]); w.z = cvt_pk_bf16(v1[0], v1[1]); w.w = cvt_pk_bf16(v1[2], v1[3]);
                    *(u32x4*)(rowp + bj * HALF) = w; } }
    }
};

struct EpiResF32 {
    static constexpr bool PERM = false, AFTER_DRAIN = false;
    const float* base; float* out; int ldc; float sc;
    __device__ __forceinline__ void operator()(const f32x4 (&acc)[2][2][4][2], const Unit& u, int wr, int wc, int fr, int fq) const {
        const int col0 = u.pn * BM + wc * 32 + 4 * fq;
#pragma unroll
        for (int ai = 0; ai < 2; ++ai)
#pragma unroll
            for (int m = 0; m < 4; ++m) { const size_t off = (size_t)(u.pm * BM + ai * HALF + wr * 64 + m * 16 + fr) * ldc + col0;
                f32x4 bs[2][2];
#pragma unroll
                for (int bj = 0; bj < 2; ++bj)
#pragma unroll
                    for (int n = 0; n < 2; ++n) bs[bj][n] = *(const f32x4*)(base + off + bj * HALF + n * 16);
#pragma unroll
                for (int bj = 0; bj < 2; ++bj)
#pragma unroll
                    for (int n = 0; n < 2; ++n) *(f32x4*)(out + off + bj * HALF + n * 16) = bs[bj][n] + acc[ai][bj][m][n] * sc;
            }
    }
};
struct EpiNull {
    static constexpr bool PERM = false, AFTER_DRAIN = false;
    __device__ __forceinline__ void operator()(const f32x4 (&acc)[2][2][4][2], const Unit& u, int wr, int wc, int fr, int fq) const {
        f32x4 s = {0.f, 0.f, 0.f, 0.f};
#pragma unroll
        for (int ai = 0; ai < 2; ++ai)
#pragma unroll
            for (int bj = 0; bj < 2; ++bj)
#pragma unroll
                for (int m = 0; m < 4; ++m)
#pragma unroll
                    for (int n = 0; n < 2; ++n) s += acc[ai][bj][m][n];
        asm volatile("" :: "v"(s));
    }
};

struct EpiQKVn {
    static constexpr bool PERM = true, AFTER_DRAIN = false;
    bf16_t* O; int ldc; size_t split_stride; float* ksq; int seq;
    __device__ __forceinline__ void operator()(const f32x4 (&acc)[2][2][4][2], const Unit& u, int wr, int wc, int fr, int fq) const {
        const int row0 = u.pm * BM + wr * 64 + fr; int colt = u.pn * BM; const int t = colt / ldc; colt -= t * ldc;
        bf16_t* base = O + (size_t)t * split_stride; const int col0 = colt + wc * 32 + 8 * fq;
        const int lane = fr + 16 * fq;
#pragma unroll
        for (int ai = 0; ai < 2; ++ai)
#pragma unroll
            for (int m = 0; m < 4; ++m) { const int row = row0 + ai * HALF + m * 16; bf16_t* rowp = base + (size_t)row * ldc + col0;
#pragma unroll
                for (int bj = 0; bj < 2; ++bj) { const f32x4 v0 = acc[ai][bj][m][0], v1 = acc[ai][bj][m][1];
                    u32x4 w; w.x = cvt_pk_bf16(v0[0], v0[1]); w.y = cvt_pk_bf16(v0[2], v0[3]); w.z = cvt_pk_bf16(v1[0], v1[1]); w.w = cvt_pk_bf16(v1[2], v1[3]);
                    *(u32x4*)(rowp + bj * HALF) = w;
                    if (t == 1) {
                        float sq = (v0[0] * v0[0] + v0[1] * v0[1]) + (v0[2] * v0[2] + v0[3] * v0[3]) + (v1[0] * v1[0] + v1[1] * v1[1]) + (v1[2] * v1[2] + v1[3] * v1[3]);
                        sq += __builtin_bit_cast(float, __builtin_amdgcn_ds_bpermute((lane ^ 16) << 2, __builtin_bit_cast(int, sq)));
                        sq += __builtin_bit_cast(float, __builtin_amdgcn_ds_bpermute((lane ^ 32) << 2, __builtin_bit_cast(int, sq)));
                        if (fq == 0) { const int b = row / seq, head = (colt >> 7) + bj; atomicAdd(ksq + ((size_t)(b * 8 + head) * seq + (row - b * seq)), sq); }
                    } } }
    }
};
template <class Epi, class Sched, bool ALIGN_EPI = false, bool SP2 = false>
__device__ __forceinline__ void gemm_phase(PG8_LAS unsigned char* lds, const Gemm g, const Sched& S, const Epi& E, const int wave_u) {
    int tid = wave_u * 64 + fresh_lane(); asm volatile("" : "+v"(tid));
    const int wid = __builtin_amdgcn_readfirstlane(tid >> 6), lane = tid & 63, wr = wid >> 2, wc = wid & 3, fr = lane & 15, fq = lane >> 4;
    const int K = g.K, nt = K / BK;
    unsigned voffA[2], voffB[2];
#pragma unroll
    for (int i = 0; i < 2; ++i) { int R, C; stage_rc(tid * 16 + i * 8192, R, C); const int Rb = Epi::PERM ? ((R & ~31) + perm32(R & 31)) : R;
        voffA[i] = (unsigned)(R * K + C) * 2u; voffB[i] = (unsigned)(Rb * K + C) * 2u; }
    const size_t kstep = (size_t)(BK * 2);
    const size_t hstep = (size_t)HALF * K * 2;
    const size_t tstep = 2 * hstep;
    const unsigned ldsw = (unsigned)wid * 1024u;
    const int aoff = lds_byte(wr * 64 + fr, fq * 8), boff = lds_byte(wc * 32 + fr, fq * 8);
#define PG8_SA(b, h) (((b) * 2 + (h)) * HTB)
#define PG8_SB(b, h) ((4 + (b) * 2 + (h)) * HTB)
#define PG8_STAGE(bufoff, gbase, voff) do { _Pragma("unroll") for (int _i = 0; _i < 2; ++_i) \
        __builtin_amdgcn_global_load_lds((const unsigned*)((const char*)(gbase) + (voff)[_i]), (PG8_LAS unsigned*)(lds + (bufoff) + ldsw + _i * 8192), 16, 0, 0); } while (0)
#define PG8_LDA(dst, b, h) do { _Pragma("unroll") for (int m = 0; m < 4; ++m) _Pragma("unroll") for (int k = 0; k < 2; ++k) dst[m][k] = *(const PG8_LAS bf16x8*)(lds + PG8_SA(b, h) + aoff + m * 2048 + k * 1024); } while (0)
#define PG8_LDB(dst, b, h) do { _Pragma("unroll") for (int n = 0; n < 2; ++n) _Pragma("unroll") for (int k = 0; k < 2; ++k) dst[n][k] = *(const PG8_LAS bf16x8*)(lds + PG8_SB(b, h) + boff + n * 2048 + k * 1024); } while (0)
#define PG8_MMA(ai, bj, At, Bt) do { __builtin_amdgcn_s_setprio(1); _Pragma("unroll") for (int m = 0; m < 4; ++m) _Pragma("unroll") for (int n = 0; n < 2; ++n) _Pragma("unroll") for (int k = 0; k < 2; ++k) \
        acc[ai][bj][m][n] = __builtin_amdgcn_mfma_f32_16x16x32_bf16(Bt[n][k], At[m][k], acc[ai][bj][m][n], 0, 0, 0); __builtin_amdgcn_s_setprio(0); } while (0)
#define PG8_WAIT_V(n) asm volatile("s_waitcnt vmcnt(" #n ")" ::: "memory")
#define PG8_WAIT_L(n) asm volatile("s_waitcnt lgkmcnt(" #n ")" ::: "memory")
#define PG8_BAR __builtin_amdgcn_s_barrier()
#define PG8_SCHED __builtin_amdgcn_sched_barrier(0)
    Unit cur, nxt; int ui = 0;
    if (!S.next(0, cur)) return;
    f32x4 acc[2][2][4][2];
#pragma unroll
    for (int a = 0; a < 2; ++a)
#pragma unroll
        for (int b = 0; b < 2; ++b)
#pragma unroll
            for (int m = 0; m < 4; ++m)
#pragma unroll
                for (int n = 0; n < 2; ++n) acc[a][b][m][n] = (f32x4){0.f, 0.f, 0.f, 0.f};
    bf16x8 At[4][2], B0[2][2], B1[2][2];
    const char* cA = (const char*)g.A + (size_t)cur.pm * tstep; const char* cB = (const char*)g.Bt + (size_t)cur.pn * tstep;
    S.a_ready(cur);
    if constexpr (SP2) {
        PG8_STAGE(PG8_SB(0, 0), cB, voffB); PG8_STAGE(PG8_SB(0, 1), cB + hstep, voffB); PG8_STAGE(PG8_SA(0, 0), cA, voffA); PG8_STAGE(PG8_SA(0, 1), cA + hstep, voffA);
        if (wr == 1) PG8_BAR;
        PG8_WAIT_V(2); PG8_BAR;
        PG8_STAGE(PG8_SB(1, 0), cB + kstep, voffB); PG8_STAGE(PG8_SA(1, 0), cA + kstep, voffA); PG8_STAGE(PG8_SB(1, 1), cB + hstep + kstep, voffB);
        PG8_WAIT_V(6); PG8_BAR;
    } else {
        PG8_STAGE(PG8_SB(0, 0), cB, voffB); PG8_STAGE(PG8_SA(0, 0), cA, voffA); PG8_STAGE(PG8_SB(0, 1), cB + hstep, voffB); PG8_STAGE(PG8_SA(0, 1), cA + hstep, voffA);
        if (wr == 1) PG8_BAR;
        PG8_WAIT_V(4); PG8_BAR;
        PG8_STAGE(PG8_SB(1, 0), cB + kstep, voffB); PG8_STAGE(PG8_SA(1, 0), cA + kstep, voffA); PG8_STAGE(PG8_SB(1, 1), cB + hstep + kstep, voffB);
        PG8_WAIT_V(6); PG8_BAR;
    }
    for (;;) {
        const bool has_next = S.next(ui + 1, nxt);
        const char* nA = has_next ? (const char*)g.A + (size_t)nxt.pm * tstep : cA; const char* nB = has_next ? (const char*)g.Bt + (size_t)nxt.pn * tstep : cB;
        for (int t = 0; t < nt; t += 2) {
            const bool last = (t == nt - 2);
            const char* a1 = cA + (size_t)(t + 1) * kstep;
            const char* a2 = last ? nA : cA + (size_t)(t + 2) * kstep; const char* b2 = last ? nB : cB + (size_t)(t + 2) * kstep;
            const char* a3 = a2 + kstep; const char* b3 = b2 + kstep;
            if (last && has_next) S.a_ready(nxt);
            if constexpr (SP2) {
            PG8_LDB(B0, 0, 0); PG8_LDB(B1, 0, 1); PG8_SCHED; PG8_LDA(At, 0, 0); PG8_STAGE(PG8_SA(1, 1), a1 + hstep, voffA);
            PG8_WAIT_V(8); PG8_WAIT_L(0); PG8_BAR; PG8_MMA(0, 0, At, B0); PG8_MMA(0, 1, At, B1); PG8_BAR; PG8_SCHED;
            PG8_LDA(At, 0, 1); PG8_STAGE(PG8_SB(0, 0), b2, voffB); PG8_STAGE(PG8_SB(0, 1), b2 + hstep, voffB); PG8_STAGE(PG8_SA(0, 0), a2, voffA);
            PG8_WAIT_V(8); PG8_WAIT_L(0); PG8_BAR; PG8_MMA(1, 0, At, B0); PG8_MMA(1, 1, At, B1); PG8_BAR; PG8_SCHED;
            PG8_LDB(B0, 1, 0); PG8_LDB(B1, 1, 1); PG8_SCHED; PG8_LDA(At, 1, 0); PG8_STAGE(PG8_SA(0, 1), a2 + hstep, voffA);
            PG8_WAIT_V(8); PG8_WAIT_L(0); PG8_BAR; PG8_MMA(0, 0, At, B0); PG8_MMA(0, 1, At, B1); PG8_BAR; PG8_SCHED;
            PG8_LDA(At, 1, 1); PG8_STAGE(PG8_SB(1, 0), b3, voffB); PG8_STAGE(PG8_SB(1, 1), b3 + hstep, voffB); PG8_STAGE(PG8_SA(1, 0), a3, voffA);
            PG8_WAIT_V(8); PG8_WAIT_L(0); PG8_BAR; PG8_MMA(1, 0, At, B0); PG8_MMA(1, 1, At, B1); PG8_BAR; PG8_SCHED;
            } else {
            PG8_LDB(B0, 0, 0); PG8_SCHED; PG8_LDA(At, 0, 0); PG8_STAGE(PG8_SA(1, 1), a1 + hstep, voffA);
            PG8_WAIT_L(8); PG8_BAR; PG8_WAIT_L(0); PG8_MMA(0, 0, At, B0); PG8_BAR; PG8_SCHED;
            PG8_LDB(B1, 0, 1); PG8_STAGE(PG8_SB(0, 0), b2, voffB);
            PG8_BAR; PG8_WAIT_L(0); PG8_MMA(0, 1, At, B1); PG8_BAR;
            PG8_LDA(At, 0, 1); PG8_STAGE(PG8_SA(0, 0), a2, voffA);
            PG8_BAR; PG8_WAIT_L(0); PG8_MMA(1, 0, At, B0); PG8_BAR; PG8_SCHED;
            PG8_STAGE(PG8_SB(0, 1), b2 + hstep, voffB);
            PG8_WAIT_V(6); PG8_BAR; PG8_MMA(1, 1, At, B1); PG8_BAR;
            PG8_LDB(B0, 1, 0); PG8_SCHED; PG8_LDA(At, 1, 0); PG8_STAGE(PG8_SA(0, 1), a2 + hstep, voffA);
            PG8_WAIT_L(8); PG8_BAR; PG8_WAIT_L(0); PG8_MMA(0, 0, At, B0); PG8_BAR; PG8_SCHED;
            PG8_LDB(B1, 1, 1); PG8_STAGE(PG8_SB(1, 0), b3, voffB);
            PG8_BAR; PG8_WAIT_L(0); PG8_MMA(0, 1, At, B1); PG8_BAR;
            PG8_LDA(At, 1, 1); PG8_STAGE(PG8_SA(1, 0), a3, voffA);
            PG8_BAR; PG8_WAIT_L(0); PG8_MMA(1, 0, At, B0); PG8_BAR; PG8_SCHED;
            PG8_STAGE(PG8_SB(1, 1), b3 + hstep, voffB);
            PG8_WAIT_V(6); PG8_BAR; PG8_MMA(1, 1, At, B1); PG8_BAR;
            }
        }
        if constexpr (ALIGN_EPI) { if (wr == 0) PG8_BAR; }
        if constexpr (!Epi::AFTER_DRAIN) { E(acc, cur, wr, wc, fr, fq); S.done(cur); }
        if (!has_next) break;
#pragma unroll
        for (int a = 0; a < 2; ++a)
#pragma unroll
            for (int b = 0; b < 2; ++b)
#pragma unroll
                for (int m = 0; m < 4; ++m)
#pragma unroll
                    for (int n = 0; n < 2; ++n) acc[a][b][m][n] = (f32x4){0.f, 0.f, 0.f, 0.f};
        cur = nxt; cA = nA; cB = nB; ++ui;
        if constexpr (ALIGN_EPI) { if (wr == 1) PG8_BAR; }
    }
    PG8_WAIT_V(0);
    if constexpr (!ALIGN_EPI) { if (wr == 0) PG8_BAR; }
    PG8_BAR;
    if constexpr (Epi::AFTER_DRAIN) { E.fused(acc, cur, wr, wc, fr, fq, lds, wid, lane); S.done(cur); }
#undef PG8_SA
#undef PG8_SB
#undef PG8_STAGE
#undef PG8_LDA
#undef PG8_LDB
#undef PG8_MMA
#undef PG8_WAIT_V
#undef PG8_WAIT_L
#undef PG8_BAR
#undef PG8_SCHED
}
}
namespace swa {
constexpr int D = 128;
constexpr float THR = 8.f;
constexpr float SCALE = 0.08838834764831845f;
constexpr int NW = 8, QBLK = 32, KVBLK = 64, QB = NW * QBLK;
constexpr int SHM_V = KVBLK * D * 2, SHM_K = KVBLK * D * 2;
constexpr int NVS = 3;
constexpr int OFF_WS = NVS * SHM_V + 2 * SHM_K;
constexpr int OFF_CS = OFF_WS + NW * 64 * 4;
constexpr int OFF_SC = OFF_CS + 4096 * 8;
constexpr int LDS_BYTES = OFF_SC + 128;
constexpr int TABN = 320, TABOFF = 96;
#ifndef PIPE2
#define PIPE2 0
#endif

using bf16 = __hip_bfloat16;
typedef short bf16x8 __attribute__((ext_vector_type(8)));
typedef short s16x4 __attribute__((ext_vector_type(4)));
typedef float f32x16 __attribute__((ext_vector_type(16)));
typedef float f32x4 __attribute__((ext_vector_type(4)));
typedef unsigned u32x4 __attribute__((ext_vector_type(4)));
typedef unsigned u32x2 __attribute__((ext_vector_type(2)));

#define KSWZ(row, colB) ((row) * 256 + ((colB) ^ (((row) & 7) << 4)))
#define SBAR() __builtin_amdgcn_sched_barrier(0)
__device__ __forceinline__ int v_st(int k, int c) { const int kk = (k & ~0xC) | ((k & 4) << 1) | ((k & 8) >> 1); return ((kk >> 3) * 4 + (c >> 5)) * 512 + ((kk & 7) * 32 + (c & 31)) * 2; }
__device__ __forceinline__ int v_rd_base(int lane) { return ((lane & 3) << 3) | (((lane >> 2) & 3) << 6) | (((lane >> 4) & 1) << 5) | (((lane >> 5) & 1) << 8); }
constexpr int v_rd_off(int d0, int ks, int half) { return d0 * 512 + ks * 4096 + half * 2048; }
__device__ __forceinline__ int crow(int r, int hi) { return (r & 3) + 8 * (r >> 2) + 4 * hi; }
__device__ __forceinline__ unsigned cvtpk(float lo, float hi) { unsigned r; asm volatile("v_cvt_pk_bf16_f32 %0, %1, %2" : "=v"(r) : "v"(lo), "v"(hi)); return r; }
__device__ __forceinline__ bf16x8 load8(const bf16* p) { return *reinterpret_cast<const bf16x8*>(p); }

__device__ __forceinline__ void mask_tile(f32x16& p0, f32x16& p1, int dq, unsigned W) {
    const float NEG = -__builtin_inff();
#pragma unroll
    for (int r = 0; r < 16; ++r) {
        const int c = (r & 3) + 8 * (r >> 2);
        if ((unsigned)(dq - c) >= W) p0[r] = NEG;
        if ((unsigned)(dq - c - 32) >= W) p1[r] = NEG;
    }
}
__device__ __forceinline__ void bias_mask_tile(f32x16& p0, f32x16& p1, int dq, unsigned W, const float* tab) {
    const float NEG = -__builtin_inff();
    const float* tb = tab + TABOFF + dq;
#pragma unroll
    for (int q = 0; q < 4; ++q) {
#pragma unroll
        for (int e = 0; e < 4; ++e) { const int r = 4 * q + e, c = e + 8 * q;
            const float b0 = tb[-c], b1 = tb[-c - 32];
            p0[r] = ((unsigned)(dq - c) >= W) ? NEG : p0[r] + b0;
            p1[r] = ((unsigned)(dq - c - 32) >= W) ? NEG : p1[r] + b1; }
        asm volatile("" ::: "memory");
    }
}
__device__ __forceinline__ void partialSM(f32x16& p0, f32x16& p1, float& m_reg, float& mn, float& alpha) {
    float pmax = p0[0]; for (int r = 1; r < 16; ++r) pmax = fmaxf(pmax, p0[r]); for (int r = 0; r < 16; ++r) pmax = fmaxf(pmax, p1[r]);
    { auto rr = __builtin_amdgcn_permlane32_swap(__float_as_uint(pmax), __float_as_uint(pmax), false, false);
      pmax = fmaxf(__uint_as_float(rr[0]), __uint_as_float(rr[1])); }
    constexpr float C2 = 1.4426950408889634f * SCALE;
    if (__builtin_expect(__all((pmax - m_reg) * SCALE <= THR), 1)) { mn = m_reg; alpha = 1.f; }
    else { mn = fmaxf(m_reg, pmax); alpha = __builtin_amdgcn_exp2f((m_reg - mn) * C2); m_reg = mn; }
    const float mnL = -mn * C2;
    for (int r = 0; r < 16; ++r) p0[r] = fmaf(p0[r], C2, mnL); for (int r = 0; r < 16; ++r) p1[r] = fmaf(p1[r], C2, mnL);
    for (int r = 0; r < 16; ++r) p0[r] = __builtin_amdgcn_exp2f(p0[r]);
}
__device__ __forceinline__ void finishSM(f32x16& p0, f32x16& p1, float alpha, float& l_reg, bf16x8& pa0, bf16x8& pa1, bf16x8& pa2, bf16x8& pa3) {
    for (int r = 0; r < 16; ++r) p1[r] = __builtin_amdgcn_exp2f(p1[r]);
    float ps = 0; for (int r = 0; r < 16; ++r) ps += p0[r]; for (int r = 0; r < 16; ++r) ps += p1[r];
    { auto rr = __builtin_amdgcn_permlane32_swap(__float_as_uint(ps), __float_as_uint(ps), false, false);
      ps = __uint_as_float(rr[0]) + __uint_as_float(rr[1]); }
    l_reg = l_reg * alpha + ps;
#define PK4(P, B_, OUT) do { unsigned a0 = cvtpk(P[B_+0], P[B_+1]), a1 = cvtpk(P[B_+2], P[B_+3]);                          \
        unsigned b0 = cvtpk(P[B_+4], P[B_+5]), b1 = cvtpk(P[B_+6], P[B_+7]);                                             \
        auto r0 = __builtin_amdgcn_permlane32_swap(a0, b0, false, false); auto r1 = __builtin_amdgcn_permlane32_swap(a1, b1, false, false); \
        u32x4 w = {r0[0], r1[0], r0[1], r1[1]}; OUT = *reinterpret_cast<bf16x8*>(&w); } while (0)
    PK4(p0, 0, pa0); PK4(p0, 8, pa1); PK4(p1, 0, pa2); PK4(p1, 8, pa3);
#undef PK4
}
#define KRD(dst, base, off) asm volatile("ds_read_b128 %0, %1 offset:%2" : "=&v"(dst) : "v"(base), "i"(off) : "memory")
#define SB_ALU() __builtin_amdgcn_sched_barrier(0)
template <int KB, bool SK, int MODE>
__device__ __forceinline__ void qkt(f32x16& p0, f32x16& p1, const int* kba, int r32, int hi, const bf16x8* qr, bool act, const unsigned long long* csk, const unsigned long long* csq) {
    if (SK && !act) { const float NEG = -__builtin_inff();
#pragma unroll
        for (int r = 0; r < 16; ++r) { p0[r] = NEG; p1[r] = NEG; } return; }
    constexpr int OB = KB * SHM_K;
    bf16x8 a0, a1, b0, b1;
    KRD(a0, kba[0], OB); KRD(a1, kba[0], OB + 8192); KRD(b0, kba[1], OB); KRD(b1, kba[1], OB + 8192);
    p0 = f32x16{}; p1 = f32x16{};
    if constexpr (MODE == 1) {
        const u32x2 t0 = *(const u32x2*)(csk), t1 = *(const u32x2*)(csk + 32), tq = *(const u32x2*)(csq);
        const u32x4 qv = {0x3f803f80u, 0x00003f80u, tq.x ^ 0x80008000u, tq.y ^ 0x00008000u};
        const bf16x8 qx = hi ? bf16x8{} : __builtin_bit_cast(bf16x8, qv);
        const u32x4 k0 = {t0.x, t0.y, 0x3f803f80u, 0x00003f80u}, k1 = {t1.x, t1.y, 0x3f803f80u, 0x00003f80u};
        p0 = __builtin_amdgcn_mfma_f32_32x32x16_bf16(__builtin_bit_cast(bf16x8, k0), qx, p0, 0, 0, 0);
        p1 = __builtin_amdgcn_mfma_f32_32x32x16_bf16(__builtin_bit_cast(bf16x8, k1), qx, p1, 0, 0, 0);
    }
#define QK_STEP(X0, X1, d0, NB, LD0) do { asm volatile("s_waitcnt lgkmcnt(%0)" :: "i"(NB) : "memory"); SB_ALU(); \
        p0 = __builtin_amdgcn_mfma_f32_32x32x16_bf16(X0, qr[d0], p0, 0, 0, 0); p1 = __builtin_amdgcn_mfma_f32_32x32x16_bf16(X1, qr[d0], p1, 0, 0, 0); SB_ALU(); \
        if (LD0 < 8) { KRD(X0, kba[(LD0) & 3], OB + ((LD0) >> 2) * 128); KRD(X1, kba[(LD0) & 3], OB + ((LD0) >> 2) * 128 + 8192); } } while (0)
    __builtin_amdgcn_s_setprio(1);
    QK_STEP(a0, a1, 0, 2, 2); QK_STEP(b0, b1, 1, 2, 3); QK_STEP(a0, a1, 2, 2, 4); QK_STEP(b0, b1, 3, 2, 5);
    QK_STEP(a0, a1, 4, 2, 6); QK_STEP(b0, b1, 5, 2, 7); QK_STEP(a0, a1, 6, 2, 8); QK_STEP(b0, b1, 7, 0, 9);
    __builtin_amdgcn_s_setprio(0);
#undef QK_STEP
}
template <int VB, bool SK>
__device__ __forceinline__ void pv_tile(f32x16* o, int vb0, bf16x8 pa0, bf16x8 pa1, bf16x8 pa2, bf16x8 pa3, bool act) {
    if (SK && !act) return;
#define TRRD(dst, off) asm volatile("ds_read_b64_tr_b16 %0, %1 offset:%2" : "=&v"(dst) : "v"(vb0), "i"(off) : "memory")
#define PV_D0(d0) do { s16x4 l0, l1, l2, l3, h0, h1, h2, h3; constexpr int b_ = VB * SHM_V + v_rd_off(d0, 0, 0); \
        TRRD(l0, b_); TRRD(h0, b_ + 2048); TRRD(l1, b_ + 4096); TRRD(h1, b_ + 6144); TRRD(l2, b_ + 8192); TRRD(h2, b_ + 10240); TRRD(l3, b_ + 12288); TRRD(h3, b_ + 14336); \
        asm volatile("s_waitcnt lgkmcnt(0)" ::: "memory"); SBAR();   \
        o[d0] = __builtin_amdgcn_mfma_f32_32x32x16_bf16(pa0, (bf16x8){l0[0], l0[1], l0[2], l0[3], h0[0], h0[1], h0[2], h0[3]}, o[d0], 0, 0, 0);   \
        o[d0] = __builtin_amdgcn_mfma_f32_32x32x16_bf16(pa1, (bf16x8){l1[0], l1[1], l1[2], l1[3], h1[0], h1[1], h1[2], h1[3]}, o[d0], 0, 0, 0);   \
        o[d0] = __builtin_amdgcn_mfma_f32_32x32x16_bf16(pa2, (bf16x8){l2[0], l2[1], l2[2], l2[3], h2[0], h2[1], h2[2], h2[3]}, o[d0], 0, 0, 0);   \
        o[d0] = __builtin_amdgcn_mfma_f32_32x32x16_bf16(pa3, (bf16x8){l3[0], l3[1], l3[2], l3[3], h3[0], h3[1], h3[2], h3[3]}, o[d0], 0, 0, 0); } while (0)
    __builtin_amdgcn_s_setprio(1); PV_D0(0); PV_D0(1); PV_D0(2); PV_D0(3); __builtin_amdgcn_s_setprio(0);
#undef PV_D0
#undef TRRD
}

struct BlockRef { const bf16* Q; const bf16* K; const bf16* V; bf16* O; float* L; const float* aux; const float* aux2; int P0, skv, W, pad; };
__device__ __forceinline__ int swa_jlo(int P0, int W) { const int lowk = P0 - W + 1; return lowk > 0 ? lowk / KVBLK : 0; }
#define ROW(p, k0, rr0, rs_) ((const bf16*)((const char*)(p) + (size_t)((k0) + (rr0)) * (size_t)(rs_) * 2 + voff))
#define VMW() asm volatile("s_waitcnt vmcnt(0)" ::: "memory")
#define SLOAD_H(Kp, Vp, k0, rs_) do { st_v0 = load8(ROW(Vp, k0, 0, rs_)); st_v1 = load8(ROW(Vp, k0, 32, rs_));              \
                         st_k0 = load8(ROW(Kp, k0, 0, rs_)); st_k1 = load8(ROW(Kp, k0, 32, rs_)); } while (0)
#define SWRITE_HK(bf) do { *(bf16x8*)(K_lds + (bf) * SHM_K + kws) = st_k0; *(bf16x8*)(K_lds + (bf) * SHM_K + kws + 32 * 256) = st_k1; } while (0)
#define SWRITE_HV(off_) do { *(bf16x8*)(V_lds + (off_) + vst0) = st_v0; *(bf16x8*)(V_lds + (off_) + vst1) = st_v1; } while (0)
template <int MODE, bool SK, int RS>
__device__ __forceinline__ void swa_block(const BlockRef& cur, char* lds, const int wave_u) {
    int tid = wave_u * 64 + fresh_lane(); asm volatile("" : "+v"(tid));
    const int wid = __builtin_amdgcn_readfirstlane(tid >> 6), lane = tid & 63, r32 = lane & 31, hi = lane >> 5;
    const int W = cur.W, skv = cur.skv; constexpr int rs = RS;
    int j_lo = swa_jlo(cur.P0, W);
    int j_hi = (cur.P0 + QB - 1) / KVBLK + 1; if (j_hi > skv / KVBLK) j_hi = skv / KVBLK;
    const int qlo = cur.P0 + wid * QBLK, qm = qlo + r32 - 4 * hi;
    char* V_lds = lds; char* K_lds = lds + NVS * SHM_V;
    float* ws = (float*)(lds + OFF_WS) + wid * 64; float* li_l = ws, * al_l = ws + 32;
    const int sr = tid >> 4, sc = (tid & 15) * 8, vst0 = v_st(sr, sc), vst1 = v_st(32 + sr, sc), kws = KSWZ(sr, sc * 2);
    const unsigned voff = (unsigned)(sr * RS + sc) * 2u, qoff = (unsigned)(r32 * RS + hi * 8) * 2u;
    const int vb0 = (int)(uintptr_t)V_lds + v_rd_base(lane);
    int kba[4];
#pragma unroll
    for (int dd = 0; dd < 4; ++dd) kba[dd] = (int)(uintptr_t)K_lds + KSWZ(r32, (dd * 16 + hi * 8) * 2);
    const bf16* Kh = cur.K; const bf16* Vh = cur.V;
    bf16x8 qr[8], st_v0, st_v1, st_k0, st_k1;
#define KBASE(t) ((j_lo + (t)) * KVBLK)
    { const char* qb_ = (const char*)(cur.Q + (size_t)(cur.P0 + wid * QBLK) * RS);
#pragma unroll
      for (int d0 = 0; d0 < 8; ++d0) qr[d0] = load8((const bf16*)(qb_ + qoff + d0 * 32)); }
    if constexpr (MODE != 1) { SLOAD_H(Kh, Vh, KBASE(0), RS); }
    unsigned long long* cs = (unsigned long long*)(lds + OFF_CS);
    if constexpr (MODE == 1) {
        float* sc8 = (float*)(lds + OFF_SC);
        const int n = cur.P0 + QB; const float* lf = cur.aux;
        f32x4 a = {0.f, 0.f, 0.f, 0.f}, b = {0.f, 0.f, 0.f, 0.f};
        if (8 * tid < n) { a = *(const f32x4*)(lf + 8 * tid); b = *(const f32x4*)(lf + 8 * tid + 4); }
        a[1] += a[0]; a[2] += a[1]; a[3] += a[2]; b[0] += a[3]; b[1] += b[0]; b[2] += b[1]; b[3] += b[2];
        const float tot = b[3]; float inc = tot;
#pragma unroll
        for (int o_ = 1; o_ < 64; o_ <<= 1) { const float v = __builtin_bit_cast(float, __builtin_amdgcn_ds_bpermute((lane - o_) << 2, __builtin_bit_cast(int, inc))); if (lane >= o_) inc += v; }
        if (lane == 63) sc8[wid] = inc;
        __syncthreads();
        float base = inc - tot;
        for (int w = 0; w < wid; ++w) base += sc8[w];
        const float ninv = -1.f / SCALE;
        if (8 * tid < n) {
#pragma unroll
            for (int e = 0; e < 8; ++e) { const float v = ((e < 4 ? a[e & 3] : b[e & 3]) + base) * ninv;
                const unsigned h = cvtpk(v, 0.f) & 0xffffu; const float r1 = v - __uint_as_float(h << 16);
                const unsigned m = cvtpk(r1, 0.f) & 0xffffu; const float r2 = r1 - __uint_as_float(m << 16);
                const unsigned lo = cvtpk(r2, 0.f) & 0xffffu;
                cs[8 * tid + e] = (unsigned long long)(h | (m << 16)) | ((unsigned long long)lo << 32); }
        }
        float kmx = 0.f;
        if (8 * tid < n) { const f32x4 ka = *(const f32x4*)(cur.aux2 + 8 * tid), kb2 = *(const f32x4*)(cur.aux2 + 8 * tid + 4);
            kmx = fmaxf(fmaxf(fmaxf(ka[0], ka[1]), fmaxf(ka[2], ka[3])), fmaxf(fmaxf(kb2[0], kb2[1]), fmaxf(kb2[2], kb2[3]))); }
        float qsq = 0.f;
#pragma unroll
        for (int d0 = 0; d0 < 8; ++d0)
#pragma unroll
            for (int e = 0; e < 8; ++e) { const float qv = __uint_as_float((unsigned)(unsigned short)qr[d0][e] << 16); qsq += qv * qv; }
        { auto rr = __builtin_amdgcn_permlane32_swap(__float_as_uint(qsq), __float_as_uint(qsq), false, false); qsq = __uint_as_float(rr[0]) + __uint_as_float(rr[1]); }
#pragma unroll
        for (int o_ = 1; o_ < 64; o_ <<= 1) { kmx = fmaxf(kmx, __builtin_bit_cast(float, __builtin_amdgcn_ds_bpermute((lane ^ o_) << 2, __builtin_bit_cast(int, kmx))));
                                              qsq = fmaxf(qsq, __builtin_bit_cast(float, __builtin_amdgcn_ds_bpermute((lane ^ o_) << 2, __builtin_bit_cast(int, qsq)))); }
        if (lane == 0) { sc8[8 + wid] = kmx; sc8[16 + wid] = qsq; }
        __syncthreads();
        {   float km = sc8[8], qmx = sc8[16];
#pragma unroll
            for (int w = 1; w < NW; ++w) { km = fmaxf(km, sc8[8 + w]); qmx = fmaxf(qmx, sc8[16 + w]); }
            const float G = 2.04f * sqrtf(km * qmx) + THR / SCALE;
            auto tabv = [&](int s_) { const unsigned long long t_ = cs[s_]; float r_; const float a_ = __uint_as_float((unsigned)t_ << 16), b_ = __uint_as_float((unsigned)t_ & 0xffff0000u), c_ = __uint_as_float((unsigned)(t_ >> 32) << 16);
                asm("v_add_f32_e32 %0, %1, %2\n\tv_add_f32_e32 %0, %0, %3" : "=&v"(r_) : "v"(a_), "v"(b_), "v"(c_)); return r_; };
            const float v0 = tabv(cur.P0);
            const int jt = lane;
            bool skip = false;
            if (jt < j_hi) skip = (G + tabv(KVBLK * jt + KVBLK - 1) - v0) * (1.4426950408889634f * SCALE) < -160.f;
            const unsigned long long bal = __builtin_amdgcn_ballot_w64(skip);
            int nskip = (~bal == 0ull) ? 64 : __builtin_ctzll(~bal);
            nskip &= ~1;
            if (nskip > j_hi - 4) nskip = (j_hi - 4) & ~1;
            if (nskip < 0) nskip = 0;
            j_lo = __builtin_amdgcn_readfirstlane(nskip);
        }
        SLOAD_H(Kh, Vh, KBASE(0), RS);
    }
    const int NT = j_hi - j_lo;
    if constexpr (MODE == 2) { if (tid < TABN) ((float*)cs)[tid] = cur.aux[tid]; }
    VMW(); SWRITE_HV(0); SWRITE_HK(0);
    __syncthreads();
    float m_reg = -1e30f, l_reg = 0; f32x16 o[4] = {};
#define RESC(a) do { if (__any((a) < 1.f)) { if (hi == 0) al_l[r32] = (a); asm volatile("s_waitcnt lgkmcnt(0)" ::: "memory");              \
                     for (int d_ = 0; d_ < 4; ++d_) for (int r = 0; r < 16; ++r) o[d_][r] *= al_l[crow(r, hi)]; } } while (0)
#define ACT(t) (KBASE(t) <= qlo + QBLK - 1 && KBASE(t) + KVBLK - 1 >= qlo - W + 1)
#define MASKT(P0_, P1_, t) do { const int kb_ = KBASE(t); \
        if constexpr (MODE == 2) { bias_mask_tile(P0_, P1_, qm - kb_, (unsigned)W, (const float*)cs); } \
        else { if (kb_ + KVBLK - 1 > qlo || kb_ <= qlo + QBLK - 1 - W) mask_tile(P0_, P1_, qm - kb_, (unsigned)W); } } while (0)
#define CSK(t) (cs + KBASE(t) + r32)
    const unsigned long long* const qx = cs + cur.P0 + wid * QBLK + r32;
    if constexpr (MODE == 1 || PIPE2) {
    int vs_prev = 0, vs_cur = 0, vs_next = SHM_V;
#define ROTV() do { vs_prev = vs_cur; vs_cur = vs_next; vs_next = (vs_next == (NVS - 1) * SHM_V) ? 0 : vs_next + SHM_V; } while (0)
#define STAGE_BAR(t, BUF) do { \
        if ((t) + 1 < NT) { VMW(); SWRITE_HK((BUF) ^ 1); SWRITE_HV(vs_next); } \
        asm volatile("s_waitcnt vmcnt(0) lgkmcnt(0)\n\ts_barrier" ::: "memory"); \
        if ((t) + 2 < NT) { SLOAD_H(Kh, Vh, KBASE((t) + 2), RS); } SBAR(); ROTV(); } while (0)
    f32x16 pA0, pA1, pB0, pB1; float mnA, mnB, alA, alB; bf16x8 pa0, pa1, pa2, pa3;
    if (NT > 1) { SLOAD_H(Kh, Vh, KBASE(1), RS); } SBAR();
    qkt<0, SK, MODE>(pA0, pA1, kba, r32, hi, qr, ACT(0), CSK(0), qx);
    if (!SK || ACT(0)) MASKT(pA0, pA1, 0);
    partialSM(pA0, pA1, m_reg, mnA, alA);
    STAGE_BAR(0, 0);
#define HALF_STEP(PX0, PX1, mnX, alX, PY0, PY1, alY, t, KB) do { \
        SBAR(); qkt<KB, SK, MODE>(PX0, PX1, kba, r32, hi, qr, ACT(t), CSK(t), qx); \
        finishSM(PY0, PY1, alY, l_reg, pa0, pa1, pa2, pa3); SBAR(); \
        pv_tile<0, SK>(o, vb0 + vs_prev, pa0, pa1, pa2, pa3, ACT((t) - 1)); \
        if (!SK || ACT(t)) MASKT(PX0, PX1, (t)); partialSM(PX0, PX1, m_reg, mnX, alX); \
        RESC(alX); \
        STAGE_BAR(t, KB); } while (0)
    for (int t = 1; t + 1 < NT; t += 2) {
        HALF_STEP(pB0, pB1, mnB, alB, pA0, pA1, alA, t, 1);
        HALF_STEP(pA0, pA1, mnA, alA, pB0, pB1, alB, t + 1, 0);
    }
    HALF_STEP(pB0, pB1, mnB, alB, pA0, pA1, alA, NT - 1, 1);
    finishSM(pB0, pB1, alB, l_reg, pa0, pa1, pa2, pa3); SBAR();
    pv_tile<0, SK>(o, vb0 + vs_prev, pa0, pa1, pa2, pa3, ACT(NT - 1));
#undef HALF_STEP
#undef STAGE_BAR
#undef ROTV
    } else {
    const bool grpB = wid >= 4;
    int vs_cur = 0, vs_next = SHM_V;
    bf16x8 u_v0, u_v1, u_k0, u_k1;
#define SLOAD_U(Kp, Vp, k0, rs_) do { u_v0 = load8(ROW(Vp, k0, 0, rs_)); u_v1 = load8(ROW(Vp, k0, 32, rs_)); u_k0 = load8(ROW(Kp, k0, 0, rs_)); u_k1 = load8(ROW(Kp, k0, 32, rs_)); } while (0)
#define SWRITE_U(bf, off_) do { *(bf16x8*)(K_lds + (bf) * SHM_K + kws) = u_k0; *(bf16x8*)(K_lds + (bf) * SHM_K + kws + 32 * 256) = u_k1; \
        *(bf16x8*)(V_lds + (off_) + vst0) = u_v0; *(bf16x8*)(V_lds + (off_) + vst1) = u_v1; } while (0)
#define STAGE_BAR(t, BUF) do { \
        if ((t) + 1 < NT) { if ((t) + 2 < NT) asm volatile("s_waitcnt vmcnt(4)" ::: "memory"); else asm volatile("s_waitcnt vmcnt(0)" ::: "memory"); \
            if ((BUF) == 0) { SWRITE_U(1, vs_next); } else { SWRITE_HK(0); SWRITE_HV(vs_next); } } \
        asm volatile("s_waitcnt lgkmcnt(0)\n\ts_barrier" ::: "memory"); \
        if ((t) + 3 < NT) { if ((BUF) == 0) { SLOAD_U(Kh, Vh, KBASE((t) + 3), RS); } else { SLOAD_H(Kh, Vh, KBASE((t) + 3), RS); } } SBAR(); } while (0)
#define TILE(t, BUF) do { \
        const bool act_ = !SK || ACT(t); bf16x8 pa0, pa1, pa2, pa3; \
        if (act_) { f32x16 p0, p1; float mn, al; \
            qkt<BUF, false, MODE>(p0, p1, kba, r32, hi, qr, true, CSK(t), qx); \
            MASKT(p0, p1, t); partialSM(p0, p1, m_reg, mn, al); RESC(al); \
            finishSM(p0, p1, al, l_reg, pa0, pa1, pa2, pa3); SBAR(); } \
        if (grpB) STAGE_BAR(t, BUF); \
        if (act_) { pv_tile<0, false>(o, vb0 + vs_cur, pa0, pa1, pa2, pa3, true); SBAR(); } \
        if (!grpB) STAGE_BAR(t, BUF); \
        vs_cur = vs_next; vs_next = (vs_next == (NVS - 1) * SHM_V) ? 0 : vs_next + SHM_V; } while (0)
    if (NT > 1) { SLOAD_U(Kh, Vh, KBASE(1), RS); } SBAR();
    if (NT > 2) { SLOAD_H(Kh, Vh, KBASE(2), RS); } SBAR();
    for (int t = 0; t < NT; t += 2) { TILE(t, 0); TILE(t + 1, 1); }
#undef SLOAD_U
#undef SWRITE_U
#undef STAGE_BAR
    }
    {
        int tid2 = wave_u * 64 + fresh_lane(); asm volatile("" : "+v"(tid2));
        const int r32e = tid2 & 31, hie = (tid2 >> 5) & 1;
        if (hie == 0) li_l[r32e] = l_reg; asm volatile("s_waitcnt lgkmcnt(0)" ::: "memory");
        float rli[16];
#pragma unroll
        for (int r = 0; r < 16; ++r) rli[r] = __builtin_amdgcn_rcpf(li_l[crow(r, hie)]);
        char* Ow = (char*)(cur.O + (size_t)(cur.P0 + wid * QBLK) * rs);
        const unsigned ooff = (unsigned)(4 * hie * rs + r32e) * 2u;
#pragma unroll
        for (int r = 0; r < 16; ++r) { const unsigned orow = (unsigned)(((r & 3) + 8 * (r >> 2)) * rs) * 2u;
#pragma unroll
            for (int d0 = 0; d0 < 4; ++d0) { const float v = o[d0][r] * rli[r];
                const float vn = __builtin_bit_cast(float, __builtin_amdgcn_update_dpp(0, __builtin_bit_cast(int, v), 0xB1, 0xF, 0xF, false));
                if ((r32e & 1) == 0) *(unsigned*)(Ow + ooff + orow + d0 * 64) = cvtpk(v, vn); } }
        if constexpr (MODE == 2) { if (hie == 0) cur.L[(size_t)(cur.P0 + wid * QBLK + r32e) * (RS / 128)] = m_reg * SCALE + __logf(l_reg); }
    }
    __syncthreads();
#undef RESC
#undef KBASE
#undef ACT
#undef MASKT
#undef CSK
#undef TILE
}
#undef ROW
#undef VMW
#undef SLOAD_H
#undef SWRITE_HK
#undef SWRITE_HV
#undef SWRITE_H
#undef KSWZ
#undef KRD
#undef SB_ALU
#undef SBAR
}
namespace cg = cooperative_groups;
constexpr int NWAVES = 8;
constexpr int BATCH = 4, SEQ = 4096, DM = 2048, DEPTH = 2, NHF = 8, HD = 128, DH = 1024, NIN = 6152, DFF = 8192;
constexpr int M = BATCH * SEQ;
constexpr int NQKV = 6 * DH;
constexpr float NORM_EPS = 1e-6f;
constexpr size_t MiB = 1u << 20;
constexpr size_t WS_LF = 1 * MiB;
constexpr size_t WS_BT = 1 * MiB + 768 * 1024;
constexpr size_t WS_LSE = 2 * MiB;
constexpr size_t WS_KSQ = 3 * MiB + 512 * 1024;
constexpr size_t WS_WIN = 4 * MiB, WS_WOUT = 28 * MiB, WS_W1 = 36 * MiB, WS_W2 = 68 * MiB;
constexpr size_t WS_XN = 100 * MiB;
constexpr size_t WS_QKV = 164 * MiB;
constexpr size_t WS_OP = 356 * MiB;
constexpr size_t WS_YA = 452 * MiB;
constexpr size_t WS_H = 164 * MiB;
constexpr size_t WS_D1 = 420 * MiB;
constexpr size_t WS_END = 484 * MiB;
constexpr int LDS_BYTES = 147456;

#define GAS __attribute__((address_space(1)))
#define LAS __attribute__((address_space(3)))
typedef unsigned short bf16r;
typedef unsigned v4u __attribute__((ext_vector_type(4)));
typedef unsigned v2u __attribute__((ext_vector_type(2)));
typedef float f32x4 __attribute__((ext_vector_type(4)));
#define LDS_WAIT() asm volatile("s_waitcnt lgkmcnt(0)" ::: "memory")
__device__ __forceinline__ unsigned f2bf(float f) { unsigned u = __builtin_bit_cast(unsigned, f); return (u + 0x7fffu + ((u >> 16) & 1u)) >> 16; }
__device__ __forceinline__ unsigned pk2(float lo, float hi) { return f2bf(lo) | (f2bf(hi) << 16); }
__device__ __forceinline__ float bf2f(unsigned short h) { return __builtin_bit_cast(float, (unsigned)h << 16); }
__device__ __forceinline__ float wave_sum(float v, int lane) {
#pragma unroll
    for (int o = 1; o < 64; o <<= 1) v += __builtin_bit_cast(float, __builtin_amdgcn_ds_bpermute((lane ^ o) << 2, __builtin_bit_cast(int, v)));
    return v;
}

#define XB_TMO      128
#define XB_XCNT(j)  (256  + 64 * (j))
#define XB_XSUB(j)  (1280 + 64 * (j))
#define XB_XGEN(j)  (2304 + 64 * (j))
#define XB_TOP      3328
#define XB_TOPGEN   3392
#define XCD_BAR_WORDS 3456
#define XB_SPIN_CAP (1u << 18)

__device__ __forceinline__ unsigned xb_ld(unsigned* p)              { return __hip_atomic_load(p, __ATOMIC_RELAXED, __HIP_MEMORY_SCOPE_AGENT); }
__device__ __forceinline__ unsigned xb_add(unsigned* p, unsigned v) { return __hip_atomic_fetch_add(p, v, __ATOMIC_RELAXED, __HIP_MEMORY_SCOPE_AGENT); }
__device__ __forceinline__ unsigned xb_xcc_id() { return (unsigned)__builtin_amdgcn_s_getreg((3 << 11) | 20) & 0xFu; }
#define XB_SPIN(cond, bar) do { unsigned _sp = 0; while (cond) { __builtin_amdgcn_s_sleep(1); \
    if ((++_sp & 255u) == 0u) { if (xb_ld(&(bar)[XB_TMO])) break; if (_sp > XB_SPIN_CAP) { atomicAdd(&(bar)[XB_TMO], 1u); break; } } } } while (0)

struct XcdBarrier {
    unsigned* bar; unsigned x;
    volatile LAS unsigned* st;
};

__device__ __forceinline__ XcdBarrier xcd_barrier_post(unsigned* bar, volatile LAS unsigned* st) {
    XcdBarrier b; b.bar = bar; b.x = xb_xcc_id(); b.st = st;
    if (threadIdx.x == 0) (void)xb_add(&bar[XB_XCNT(b.x)], 1u);
    return b;
}
__device__ __forceinline__ void xcd_barrier_complete(unsigned* bar, unsigned x, unsigned& nloc, unsigned& nx) {
    const unsigned G = gridDim.x * gridDim.y * gridDim.z;
    unsigned sum, cnt, mine, sp = 0u;
    for (;;) {
        sum = 0u; cnt = 0u; mine = 0u;
#pragma unroll
        for (unsigned j = 0; j < 16; ++j) { const unsigned c = xb_ld(&bar[XB_XCNT(j)]); sum += c; cnt += (c > 0u) ? 1u : 0u; mine = (j == x) ? c : mine; }
        if (sum == G) break;
        __builtin_amdgcn_s_sleep(1);
        if ((++sp & 255u) == 0u) { if (xb_ld(&bar[XB_TMO])) break; if (sp > XB_SPIN_CAP) { atomicAdd(&bar[XB_TMO], 1u); break; } }
    }
    nloc = mine > 0u ? mine : 1u; nx = cnt > 0u ? cnt : 1u;
}

__device__ __forceinline__ void xcd_barrier(const XcdBarrier& b, const bool leader  ) {
    asm volatile("s_waitcnt vmcnt(0)" ::: "memory");
    __syncthreads();
    if (leader) {
        unsigned* bar = b.bar;
        __builtin_amdgcn_s_waitcnt(0);
        unsigned nloc = b.st[0], nx = b.st[1];
        if (nloc == 0u) { xcd_barrier_complete(bar, b.x, nloc, nx); b.st[0] = nloc; b.st[1] = nx; }
        const unsigned old = xb_add(&bar[XB_XSUB(b.x)], 1u);
        const unsigned gen = old / nloc;
        if (old + 1u == (gen + 1u) * nloc) {
            __builtin_amdgcn_fence(__ATOMIC_RELEASE, "agent");
            asm volatile("s_waitcnt vmcnt(0)" ::: "memory");
            const unsigned og = xb_add(&bar[XB_TOP], 1u);
            const unsigned tg = og / nx;
            if (og + 1u == (tg + 1u) * nx) xb_add(&bar[XB_TOPGEN], 1u);
            else XB_SPIN(xb_ld(&bar[XB_TOPGEN]) == tg, bar);
            __builtin_amdgcn_fence(__ATOMIC_ACQUIRE, "agent");
            xb_add(&bar[XB_XGEN(b.x)], 1u);
            asm volatile("s_waitcnt vmcnt(0)" ::: "memory");
        } else {
            XB_SPIN(xb_ld(&bar[XB_XGEN(b.x)]) == gen, bar);
            __builtin_amdgcn_fence(__ATOMIC_ACQUIRE, "agent");
            asm volatile("s_waitcnt vmcnt(0)" ::: "memory");
        }
    }
    __syncthreads();
}

__device__ __forceinline__ f32x4 add_bf4(f32x4 v, v2u d) {
    v.x += __builtin_bit_cast(float, d.x << 16); v.y += __builtin_bit_cast(float, d.x & 0xffff0000u);
    v.z += __builtin_bit_cast(float, d.y << 16); v.w += __builtin_bit_cast(float, d.y & 0xffff0000u); return v; }
struct Args { const float* in[12]; float* out; unsigned char* ws; };

__device__ __forceinline__ void transpose_item(const float* W, int K, int ldw, int c0, int N, bf16r* WT, int row_off, LAS float* scr, int item, int lane) {
    const int nblk = N / 32, kb = item / nblk, nb = item % nblk, k0 = 64 * kb, n0 = 32 * nb;
#pragma unroll 8
    for (int i = 0; i < 32; ++i) { const int kk = 2 * i + (lane >> 5); scr[kk * 33 + (lane & 31)] = W[(size_t)(k0 + kk) * ldw + c0 + n0 + (lane & 31)]; }
    LDS_WAIT(); asm volatile("" ::: "memory");
    const int c = lane & 7;
#pragma unroll
    for (int j = 0; j < 4; ++j) { const int n = (lane >> 3) + 8 * j; const LAS float* s = scr + (8 * c) * 33 + n;
        v4u o; o.x = pk2(s[0 * 33], s[1 * 33]); o.y = pk2(s[2 * 33], s[3 * 33]); o.z = pk2(s[4 * 33], s[5 * 33]); o.w = pk2(s[6 * 33], s[7 * 33]);
        *(v4u*)(WT + (size_t)(row_off + n0 + n) * K + k0 + 8 * c) = o; }
    LDS_WAIT(); asm volatile("" ::: "memory");
}

__device__ __forceinline__ int t5_bucket(int dist) {
    if (dist < 16) return dist;
    const int thr[15] = {22, 30, 40, 54, 73, 99, 134, 182, 246, 332, 450, 609, 825, 1117, 1513};
    int b = 16;
#pragma unroll
    for (int i = 0; i < 15; ++i) b += (dist >= thr[i]) ? 1 : 0;
    return b;
}

#ifndef GEMM_WGM
#define GEMM_WGM 4
#endif
#ifndef STAGGER_US
#define STAGGER_US 0
#endif
__device__ __forceinline__ void stagger_start(int bx) {
    const unsigned long long ticks = (unsigned long long)(((bx >> 3) & 3) * STAGGER_US * 100);
    const unsigned long long t0 = __builtin_amdgcn_s_memrealtime();
    while (__builtin_amdgcn_s_memrealtime() - t0 < ticks) __builtin_amdgcn_s_sleep(4);
}
#define PHASE_PTRS() \
    const __attribute__((address_space(4))) Args* ap_ = (const __attribute__((address_space(4))) Args*)__builtin_amdgcn_kernarg_segment_ptr(); asm volatile("" : "+s"(ap_)); \
    unsigned char* const ws = ap_->ws; (void)ws; \
    const float* const x_in = ap_->in[0]; const float* const norm1_g = ap_->in[1]; const float* const w_in = ap_->in[2]; const float* const forget_b = ap_->in[3]; \
    const float* const rel_bias = ap_->in[4]; const float* const ona_g = ap_->in[5]; const float* const onb_g = ap_->in[6]; const float* const w_out = ap_->in[7]; \
    const float* const norm2_g = ap_->in[8]; const float* const w_mlp_in = ap_->in[9]; const float* const w_mlp_out = ap_->in[10]; const float* const final_g = ap_->in[11]; \
    float* const XR = ap_->out; \
    float* const KSQ = (float*)(ws + WS_KSQ); (void)KSQ; \
    float* const LF = (float*)(ws + WS_LF); float* const BT = (float*)(ws + WS_BT); float* const LSE = (float*)(ws + WS_LSE); \
    bf16r* const Win_t = (bf16r*)(ws + WS_WIN); bf16r* const Wout_t = (bf16r*)(ws + WS_WOUT); bf16r* const W1_t = (bf16r*)(ws + WS_W1); bf16r* const W2_t = (bf16r*)(ws + WS_W2); \
    bf16r* const XN = (bf16r*)(ws + WS_XN); bf16r* const QKV = (bf16r*)(ws + WS_QKV); bf16r* const OP = (bf16r*)(ws + WS_OP); bf16r* const YA = (bf16r*)(ws + WS_YA); \
    bf16r* const HB = (bf16r*)(ws + WS_H); bf16r* const D1 = (bf16r*)(ws + WS_D1); \
    (void)x_in; (void)norm1_g; (void)w_in; (void)forget_b; (void)rel_bias; (void)ona_g; (void)onb_g; (void)w_out; (void)norm2_g; (void)w_mlp_in; (void)w_mlp_out; (void)final_g; (void)XR; \
    (void)LF; (void)BT; (void)LSE; (void)Win_t; (void)Wout_t; (void)W1_t; (void)W2_t; (void)XN; (void)QKV; (void)OP; (void)YA; (void)HB; (void)D1
__global__ void __launch_bounds__(NWAVES * 64, 2) hymba_fwd(Args args) {
    extern __shared__ __attribute__((aligned(16))) unsigned char lds[];
    cg::grid_group grid = cg::this_grid();
    const int wave_u = __builtin_amdgcn_readfirstlane((int)threadIdx.x >> 6);
    volatile LAS unsigned* bst = (volatile LAS unsigned*)((LAS unsigned char*)lds + 131072);
    if (threadIdx.x < 2) bst[threadIdx.x] = 0u;
    __syncthreads();
    if (args.ws == nullptr) grid.sync();
    const XcdBarrier xbar = xcd_barrier_post((unsigned*)args.ws, bst);
    const int G = gridDim.x, bx = blockIdx.x;
    const int vcu = (G % 8 == 0) ? (bx % 8) * (G / 8) + bx / 8 : bx;
    const int NGW = G * NWAVES;
#ifdef DIAG
#define STAMP(k) do { if (blockIdx.x == 0 && threadIdx.x == 0) ((unsigned long long*)(args.ws + 512 * 1024))[(k)] = __builtin_amdgcn_s_memrealtime(); } while (0)
#else
#define STAMP(k) do {} while (0)
#endif
#define PHASE_IDS() int tid = wave_u * 64 + fresh_lane(); asm volatile("" : "+v"(tid)); const int lane = tid & 63, wave = wave_u, gw = vcu * NWAVES + wave; (void)lane; (void)gw
    constexpr size_t QSTR = (size_t)M * DH;

    { PHASE_IDS(); PHASE_PTRS();
    for (int i = gw * 64 + lane; i < 3 * 8 * swa::TABN; i += NGW * 64) {
        const int e = i % swa::TABN, h = (i / swa::TABN) % 8, p = i / (swa::TABN * 8), rel = e - swa::TABOFF, dil = (p == 0) ? 1 : (p == 1) ? 4 : 16;
        BT[i] = (rel >= 0 && rel <= 128) ? rel_bias[t5_bucket(rel * dil) * 8 + h] * (1.f / swa::SCALE) : 0.f;
    }
    }

    STAMP(0);
#pragma unroll 1
    for (int l = 0; l < DEPTH; ++l) {
#if PHASES & 1
        for (int rep_ = 0; rep_ < REP0; ++rep_) {
            PHASE_IDS(); PHASE_PTRS();
            LAS float* scr = (LAS float*)(lds) + wave * 4096;
            const float* Wi = w_in + (size_t)l * DM * NIN; const float* Wo = w_out + (size_t)l * DM * DM;
            const float* Wa = w_mlp_in + (size_t)l * DM * DFF; const float* Wb = w_mlp_out + (size_t)l * DFF * DM;
            constexpr int I_S = (DM / 64) * (DH / 32), I_O = (DM / 64) * (DM / 32), I_1 = (DM / 64) * (DFF / 32), I_2 = (DFF / 64) * (DM / 32);
            constexpr int NITEMS = 6 * I_S + I_O + I_1 + I_2;
            for (int it = gw; it < NITEMS; it += NGW) {
                int r = it;
                if (r < 6 * I_S) { const int s = r / I_S; const int c0 = s * DH + (s >= 3 ? 8 : 0); transpose_item(Wi, DM, NIN, c0, DH, Win_t, s * DH, scr, r % I_S, lane); continue; } r -= 6 * I_S;
                if (r < I_O) { transpose_item(Wo, DM, DM, 0, DM, Wout_t, 0, scr, r, lane); continue; } r -= I_O;
                if (r < I_1) { transpose_item(Wa, DM, DFF, 0, DFF, W1_t, 0, scr, r, lane); continue; } r -= I_1;
                transpose_item(Wb, DFF, DM, 0, DM, W2_t, 0, scr, r, lane);
            }
            __syncthreads();
            LAS f32x4* wf = (LAS f32x4*)lds;
            const float* g1 = norm1_g + (size_t)l * DM;
            for (int k = tid; k < DM; k += NWAVES * 64) {
                const float gk = g1[k]; const float* src = Wi + (size_t)k * NIN + 3 * DH;
                const f32x4 a = *(const f32x4*)src, b = *(const f32x4*)(src + 4);
                const int j = k >> 8, ln = (k & 255) >> 2, e = k & 3;
                wf[((j * 4 + e) * 2 + 0) * 64 + ln] = a * gk; wf[((j * 4 + e) * 2 + 1) * 64 + ln] = b * gk;
            }
            __syncthreads();
            const float* fb = forget_b + l * NHF;
            for (int m = gw; m < M; m += NGW) {
                const float* xprev = (l == 0) ? x_in : ((l == 1) ? x_in : XR);
                const f32x4* xr = (const f32x4*)(xprev + (size_t)m * DM) + lane;
                f32x4 v[8]; float ss = 0.f;
#pragma unroll
                for (int j = 0; j < 8; ++j) v[j] = xr[64 * j];
                if (l > 0) {
                    const v2u* dr = (const v2u*)(XN + (size_t)m * DM) + lane; const v2u* er = (const v2u*)(D1 + (size_t)m * DM) + lane; v2u d[8], e[8];
#pragma unroll
                    for (int j = 0; j < 8; ++j) { d[j] = dr[64 * j]; e[j] = er[64 * j]; }
                    f32x4* xw = (f32x4*)(XR + (size_t)m * DM) + lane;
#pragma unroll
                    for (int j = 0; j < 8; ++j) { v[j] = add_bf4(add_bf4(v[j], e[j]), d[j]); xw[64 * j] = v[j]; }
                }
#pragma unroll
                for (int j = 0; j < 8; ++j) ss += (v[j].x * v[j].x + v[j].y * v[j].y) + (v[j].z * v[j].z + v[j].w * v[j].w);
                f32x4 fa = {0.f, 0.f, 0.f, 0.f}, fbv = {0.f, 0.f, 0.f, 0.f};
#pragma unroll
                for (int j = 0; j < 8; ++j) {
#pragma unroll
                    for (int e = 0; e < 4; ++e) { const float xv = v[j][e]; fa += wf[((j * 4 + e) * 2 + 0) * 64 + lane] * xv; fbv += wf[((j * 4 + e) * 2 + 1) * 64 + lane] * xv; }
                    asm volatile("" ::: "memory"); }
                const float rstd = 1.f / sqrtf(wave_sum(ss, lane) * (1.f / DM) + NORM_EPS);
                float f8[8];
#pragma unroll
                for (int e = 0; e < 4; ++e) { f8[e] = wave_sum(fa[e], lane); f8[4 + e] = wave_sum(fbv[e], lane); }
                float fsel = f8[0];
#pragma unroll
                for (int e = 1; e < 8; ++e) fsel = (lane == e) ? f8[e] : fsel;
                if (lane < 8) { const float z = fsel * rstd + fb[lane]; const float ls = fminf(z, 0.f) - __logf(1.f + __expf(-fabsf(z)));
                    LF[((size_t)(m / SEQ) * NHF + lane) * SEQ + (m % SEQ)] = ls; KSQ[((size_t)(m / SEQ) * NHF + lane) * SEQ + (m % SEQ)] = 0.f; }
                const f32x4* gr = (const f32x4*)g1 + lane;
                v2u* o8 = (v2u*)(XN + (size_t)m * DM) + lane;
#pragma unroll
                for (int j = 0; j < 8; ++j) { const f32x4 g = gr[64 * j]; v2u w; w.x = pk2(v[j].x * rstd * g.x, v[j].y * rstd * g.y); w.y = pk2(v[j].z * rstd * g.z, v[j].w * rstd * g.w); o8[64 * j] = w; }
            }
        }
#endif
        xcd_barrier(xbar, wave_u == 0 && fresh_lane() == 0); STAMP(1 + l * 8 + 0);
#if REPSYNC > 1
        for (int rs_ = 0; rs_ < 8; ++rs_) xcd_barrier(xbar, wave_u == 0 && fresh_lane() == 0);
#endif
#if PHASES & 2
        for (int rep_ = 0; rep_ < REP1; ++rep_) {
            PHASE_PTRS();
            pg8::Gemm g{XN, Win_t, M, NQKV, DM}; pg8::StaticOrder S; S.init(M, NQKV, G, bx, GEMM_WGM);
            pg8::EpiQKVn E{QKV, DH, QSTR, KSQ, SEQ};
            pg8::gemm_phase<pg8::EpiQKVn, pg8::StaticOrder, true, true>((LAS unsigned char*)lds, g, S, E, wave_u);
        }
#endif
        xcd_barrier(xbar, wave_u == 0 && fresh_lane() == 0); STAMP(1 + l * 8 + 1);
        {
            PHASE_PTRS();
            const swa::bf16* Qa = (const swa::bf16*)QKV; const swa::bf16* Ka = Qa + QSTR; const swa::bf16* Va = Qa + 2 * QSTR;
            const swa::bf16* Qb = Qa + 3 * QSTR; const swa::bf16* Kb = Qa + 4 * QSTR; const swa::bf16* Vb = Qa + 5 * QSTR;
            unsigned* const qctr = (unsigned*)(ws + 15360) + l;
            volatile LAS int* const qslot = (volatile LAS int*)((LAS unsigned char*)lds + 131072 + 64);
            for (;;) {
                if (wave_u == 0 && fresh_lane() == 0) *qslot = (int)__hip_atomic_fetch_add(qctr, 1u, __ATOMIC_RELAXED, __HIP_MEMORY_SCOPE_AGENT);
                __syncthreads();
                const int it = __builtin_amdgcn_readfirstlane(*qslot);
                if (it >= 512 + 1536) break;
                if (it < 512) {
                    const int bh = it & 31, qb = 15 - (it >> 5), b = bh >> 3, h = bh & 7;
                    const size_t off = (size_t)b * SEQ * DH + h * HD;
                    swa::BlockRef r; r.Q = Qa + off; r.K = Ka + off; r.V = Va + off; r.O = (swa::bf16*)YA + off; r.L = nullptr; r.aux = LF + (size_t)bh * SEQ; r.aux2 = KSQ + (size_t)bh * SEQ;
                    r.P0 = qb * 256; r.skv = SEQ; r.W = 1 << 30; r.pad = 0;
                    swa::swa_block<1, true, DH>(r, (char*)lds, wave_u);
                } else {
                    const int g = it - 512, p = g >> 9, bh = (g >> 4) & 31, j = g & 15, b = bh >> 3, h = bh & 7;
                    const int dil = (p == 0) ? 1 : (p == 1) ? 4 : 16, nbr = 16 / dil, res = j / nbr, blk = j % nbr;
                    const size_t off = ((size_t)b * SEQ + res) * DH + h * HD;
                    swa::BlockRef r; r.Q = Qb + off; r.K = Kb + off; r.V = Vb + off; r.O = (swa::bf16*)OP + (size_t)p * QSTR + off;
                    r.L = LSE + ((size_t)p * M + (size_t)b * SEQ + res) * 8 + h; r.aux = BT + (size_t)(p * 8 + h) * swa::TABN; r.aux2 = nullptr;
                    r.P0 = blk * 256; r.skv = SEQ / dil; r.W = 129; r.pad = 0;
                    if (p == 0) swa::swa_block<2, true, DH>(r, (char*)lds, wave_u);
                    else if (p == 1) swa::swa_block<2, true, DH * 4>(r, (char*)lds, wave_u);
                    else swa::swa_block<2, true, DH * 16>(r, (char*)lds, wave_u);
                }
            }
        }
        xcd_barrier(xbar, wave_u == 0 && fresh_lane() == 0); STAMP(1 + l * 8 + 2);
#if PHASES & 16
        for (int rep_ = 0; rep_ < REP3; ++rep_) {
            PHASE_IDS(); PHASE_PTRS();
            const float* ga = ona_g + (size_t)l * DH; const float* gb = onb_g + (size_t)l * DH;
            for (int m = gw; m < M; m += NGW) {
                const int h = lane >> 3;
                const float l0 = LSE[((size_t)0 * M + m) * 8 + h], l1 = LSE[((size_t)1 * M + m) * 8 + h], l2 = LSE[((size_t)2 * M + m) * 8 + h];
                const float mx = fmaxf(l0, fmaxf(l1, l2)); float a0 = __expf(l0 - mx), a1 = __expf(l1 - mx), a2 = __expf(l2 - mx);
                const float inv = 1.f / (a0 + a1 + a2); a0 *= inv; a1 *= inv; a2 *= inv;
                const v4u* ya = (const v4u*)(YA + (size_t)m * DH) + 2 * lane;
                const v4u* o0 = (const v4u*)(OP + (size_t)m * DH) + 2 * lane; const v4u* o1 = (const v4u*)(OP + QSTR + (size_t)m * DH) + 2 * lane; const v4u* o2 = (const v4u*)(OP + 2 * QSTR + (size_t)m * DH) + 2 * lane;
                float va[16], vb[16]; float sa = 0.f, sb = 0.f;
#pragma unroll
                for (int q = 0; q < 2; ++q) { const v4u ua = ya[q], u0 = o0[q], u1 = o1[q], u2 = o2[q];
#pragma unroll
                    for (int e = 0; e < 4; ++e) {
                        const float alo = __builtin_bit_cast(float, ua[e] << 16), ahi = __builtin_bit_cast(float, ua[e] & 0xffff0000u);
                        const float blo = a0 * __builtin_bit_cast(float, u0[e] << 16) + a1 * __builtin_bit_cast(float, u1[e] << 16) + a2 * __builtin_bit_cast(float, u2[e] << 16);
                        const float bhi = a0 * __builtin_bit_cast(float, u0[e] & 0xffff0000u) + a1 * __builtin_bit_cast(float, u1[e] & 0xffff0000u) + a2 * __builtin_bit_cast(float, u2[e] & 0xffff0000u);
                        va[q * 8 + 2 * e] = alo; va[q * 8 + 2 * e + 1] = ahi; vb[q * 8 + 2 * e] = blo; vb[q * 8 + 2 * e + 1] = bhi;
                        sa += alo * alo + ahi * ahi; sb += blo * blo + bhi * bhi; } }
                const float ra = 1.f / sqrtf(wave_sum(sa, lane) * (1.f / DH) + NORM_EPS), rb = 1.f / sqrtf(wave_sum(sb, lane) * (1.f / DH) + NORM_EPS);
                const f32x4* gar = (const f32x4*)ga + 4 * lane; const f32x4* gbr = (const f32x4*)gb + 4 * lane;
                v4u* oa = (v4u*)(XN + (size_t)m * DM) + 2 * lane; v4u* ob = (v4u*)(XN + (size_t)m * DM + DH) + 2 * lane;
#pragma unroll
                for (int q = 0; q < 2; ++q) { const f32x4 g0 = gar[2 * q], g1 = gar[2 * q + 1], h0 = gbr[2 * q], h1 = gbr[2 * q + 1];
                    v4u wa, wb;
                    wa.x = pk2(va[q * 8 + 0] * ra * g0.x, va[q * 8 + 1] * ra * g0.y); wa.y = pk2(va[q * 8 + 2] * ra * g0.z, va[q * 8 + 3] * ra * g0.w);
                    wa.z = pk2(va[q * 8 + 4] * ra * g1.x, va[q * 8 + 5] * ra * g1.y); wa.w = pk2(va[q * 8 + 6] * ra * g1.z, va[q * 8 + 7] * ra * g1.w);
                    wb.x = pk2(vb[q * 8 + 0] * rb * h0.x, vb[q * 8 + 1] * rb * h0.y); wb.y = pk2(vb[q * 8 + 2] * rb * h0.z, vb[q * 8 + 3] * rb * h0.w);
                    wb.z = pk2(vb[q * 8 + 4] * rb * h1.x, vb[q * 8 + 5] * rb * h1.y); wb.w = pk2(vb[q * 8 + 6] * rb * h1.z, vb[q * 8 + 7] * rb * h1.w);
                    oa[q] = wa; ob[q] = wb; }
            }
        }
#endif
        xcd_barrier(xbar, wave_u == 0 && fresh_lane() == 0); STAMP(1 + l * 8 + 3);
#if PHASES & 32
        {
            PHASE_PTRS();
            pg8::Gemm g{XN, Wout_t, M, DM, DM}; pg8::StaticOrder S; S.init(M, DM, G, bx, GEMM_WGM);
#if REP4 > 1
            { pg8::EpiNull EN; pg8::gemm_phase<pg8::EpiNull, pg8::StaticOrder, true, true>((LAS unsigned char*)lds, g, S, EN, wave_u); }
#endif
            pg8::EpiBf16<0> E{D1, DM, nullptr, 0, 0, 1.f};
            pg8::gemm_phase<pg8::EpiBf16<0>, pg8::StaticOrder, true, true>((LAS unsigned char*)lds, g, S, E, wave_u);
        }
#endif
        xcd_barrier(xbar, wave_u == 0 && fresh_lane() == 0); STAMP(1 + l * 8 + 4);
#if PHASES & 64
        for (int rep_ = 0; rep_ < REP5; ++rep_) {
            PHASE_IDS(); PHASE_PTRS(); const float* xsrc = (l == 0) ? x_in : XR;
            const float* g2 = norm2_g + (size_t)l * DM;
            for (int m = gw; m < M; m += NGW) {
                const f32x4* xr = (const f32x4*)(xsrc + (size_t)m * DM) + lane;
                const v2u* dr = (const v2u*)(D1 + (size_t)m * DM) + lane;
                f32x4 v[8]; v2u d[8]; float ss = 0.f;
#pragma unroll
                for (int j = 0; j < 8; ++j) { v[j] = xr[64 * j]; d[j] = dr[64 * j]; }
#pragma unroll
                for (int j = 0; j < 8; ++j) { v[j] = add_bf4(v[j], d[j]); ss += (v[j].x * v[j].x + v[j].y * v[j].y) + (v[j].z * v[j].z + v[j].w * v[j].w); }
                const float rstd = 1.f / sqrtf(wave_sum(ss, lane) * (1.f / DM) + NORM_EPS);
                const f32x4* gr = (const f32x4*)g2 + lane;
                v2u* o8 = (v2u*)(XN + (size_t)m * DM) + lane;
#pragma unroll
                for (int j = 0; j < 8; ++j) { const f32x4 g = gr[64 * j]; v2u w; w.x = pk2(v[j].x * rstd * g.x, v[j].y * rstd * g.y); w.y = pk2(v[j].z * rstd * g.z, v[j].w * rstd * g.w); o8[64 * j] = w; }
            }
        }
#endif
        xcd_barrier(xbar, wave_u == 0 && fresh_lane() == 0); STAMP(1 + l * 8 + 5);
#if PHASES & 128
        for (int rep_ = 0; rep_ < REP6; ++rep_) {
            PHASE_PTRS();
            pg8::Gemm g{XN, W1_t, M, DFF, DM}; pg8::StaticOrder S; S.init(M, DFF, G, bx, GEMM_WGM);
#if REP6N > 1
            { pg8::EpiNull EN; pg8::gemm_phase<pg8::EpiNull, pg8::StaticOrder, true, true>((LAS unsigned char*)lds, g, S, EN, wave_u); }
#endif
            pg8::EpiBf16<2> E{HB, DFF, nullptr, 0, 0, 1.f};
            pg8::gemm_phase<pg8::EpiBf16<2>, pg8::StaticOrder, true, true>((LAS unsigned char*)lds, g, S, E, wave_u);
        }
#endif
        xcd_barrier(xbar, wave_u == 0 && fresh_lane() == 0); STAMP(1 + l * 8 + 6);
#if PHASES & 256
        {
            PHASE_PTRS();
            pg8::Gemm g{HB, W2_t, M, DM, DFF}; pg8::StaticOrder S; S.init(M, DM, G, bx, GEMM_WGM);
#if REP7 == 2
            { pg8::EpiNull EN; pg8::gemm_phase<pg8::EpiNull, pg8::StaticOrder, true, true>((LAS unsigned char*)lds, g, S, EN, wave_u); }
#endif
            pg8::EpiBf16<0> E{XN, DM, nullptr, 0, 0, 1.f};
            pg8::gemm_phase<pg8::EpiBf16<0>, pg8::StaticOrder, true, true>((LAS unsigned char*)lds, g, S, E, wave_u);
        }
#endif
        xcd_barrier(xbar, wave_u == 0 && fresh_lane() == 0); STAMP(1 + l * 8 + 7);
    }
    { PHASE_IDS(); PHASE_PTRS();
    for (int m = gw; m < M; m += NGW) {
        f32x4* xr = (f32x4*)(XR + (size_t)m * DM) + lane;
        const v2u* dr = (const v2u*)(XN + (size_t)m * DM) + lane; const v2u* er = (const v2u*)(D1 + (size_t)m * DM) + lane;
        f32x4 v[8]; v2u d[8], e[8]; float ss = 0.f;
#pragma unroll
        for (int j = 0; j < 8; ++j) { v[j] = xr[64 * j]; d[j] = dr[64 * j]; e[j] = er[64 * j]; }
#pragma unroll
        for (int j = 0; j < 8; ++j) { v[j] = add_bf4(add_bf4(v[j], e[j]), d[j]); ss += (v[j].x * v[j].x + v[j].y * v[j].y) + (v[j].z * v[j].z + v[j].w * v[j].w); }
        const float rstd = 1.f / sqrtf(wave_sum(ss, lane) * (1.f / DM) + NORM_EPS);
        const f32x4* gr = (const f32x4*)final_g + lane;
#pragma unroll
        for (int j = 0; j < 8; ++j) xr[64 * j] = v[j] * rstd * gr[64 * j];
    }
    }
#ifdef DIAG
    grid.sync(); STAMP(17);
    if (blockIdx.x == 0 && threadIdx.x < 64) {
        __threadfence();
        const float t1 = (float)(TS[DIAG_B1] - TS[DIAG_A1]) * 0.01f, t2 = (float)(TS[DIAG_B2] - TS[DIAG_A2]) * 0.01f;
        if (threadIdx.x == 0) XR[0] = t1;
        for (int i = threadIdx.x; i < 4096; i += 64) XR[64 + i] = t2;
    }
#endif
}

extern "C" void kernel_launch(void* const* d_in, const int* in_sizes, int n_in, void* d_out, int out_size, void* d_ws, size_t ws_size, hipStream_t stream) {
    static int grid = 0;
    if (grid == 0) {
        if (n_in != 12 || out_size != M * DM || ws_size < WS_END) { fprintf(stderr, "kernel_launch: unexpected shapes (n_in %d out %d ws %zu)\n", n_in, out_size, ws_size); grid = -1; return; }
        int dev = 0, cus = 0, per_cu = 0;
        (void)hipGetDevice(&dev); (void)hipDeviceGetAttribute(&cus, hipDeviceAttributeMultiprocessorCount, dev);
        if (hipFuncSetAttribute((const void*)hymba_fwd, hipFuncAttributeMaxDynamicSharedMemorySize, LDS_BYTES) != hipSuccess) { fprintf(stderr, "kernel_launch: hipFuncSetAttribute failed\n"); grid = -1; return; }
        if (hipOccupancyMaxActiveBlocksPerMultiprocessor(&per_cu, (const void*)hymba_fwd, NWAVES * 64, LDS_BYTES) != hipSuccess || per_cu < 1) { fprintf(stderr, "kernel_launch: occupancy query gives %d\n", per_cu); per_cu = 1; }
        (void)hipGetLastError();
        grid = cus * 1;
        if (grid <= 0) grid = 256;
    }
    if (grid < 0) return;
    if (hipMemsetAsync(d_ws, 0, 16384, stream) != hipSuccess) { fprintf(stderr, "kernel_launch: hipMemsetAsync failed\n"); return; }
    Args a{};
    for (int i = 0; i < 12; ++i) a.in[i] = (const float*)d_in[i];
    a.out = (float*)d_out; a.ws = (unsigned char*)d_ws;
    void* kargs[] = {&a};
    hipError_t e = hipLaunchCooperativeKernel((const void*)hymba_fwd, dim3(grid), dim3(NWAVES * 64), kargs, LDS_BYTES, stream);
    if (e != hipSuccess) fprintf(stderr, "kernel_launch: cooperative launch failed: %s (grid %d)\n", hipGetErrorString(e), grid);
}
```

```cpp
#include <hip/hip_runtime.h>
#include <hip/hip_cooperative_groups.h>
#include <hip/hip_bf16.h>
#include <cstdio>
#include <cstdint>
#include <cmath>
#ifndef PHASES
#define PHASES 511
#endif
#ifndef REP0
#define REP0 1
#endif
#ifndef REP1
#define REP1 1
#endif
#ifndef REP2A
#define REP2A 1
#endif
#ifndef REP2B
#define REP2B 1
#endif
#ifndef REP3
#define REP3 1
#endif
#ifndef REP5
#define REP5 1
#endif
#ifndef REP6
#define REP6 1
#endif
#ifndef REP7
#define REP7 1
#endif
#ifndef REP4
#define REP4 1
#endif
#ifndef REPSYNC
#define REPSYNC 1
#endif
#ifndef REP6N
#define REP6N 1
#endif
__device__ __forceinline__ int fresh_lane() { unsigned z = 0u; asm volatile("" : "+s"(z)); return (int)__builtin_amdgcn_mbcnt_hi(~0u, __builtin_amdgcn_mbcnt_lo(~0u, z)); }
namespace pg8 {
#define PG8_LAS __attribute__((address_space(3)))
typedef unsigned short bf16_t;
typedef short bf16x8 __attribute__((ext_vector_type(8)));
typedef float f32x4 __attribute__((ext_vector_type(4)));
typedef unsigned u32x4 __attribute__((ext_vector_type(4)));
constexpr int BM = 256, BK = 64, HALF = 128, HTB = HALF * BK * 2  , STAGE_BYTES = 8 * HTB, NXCD = 8, WGM = 8;

__host__ __device__ __forceinline__ int lds_byte(int r, int c) { const int st = (r >> 4) * 2 + (c >> 5), rr = r & 15, cc = c & 31, ob = rr * 64 + cc * 2; return st * 1024 + (ob ^ (((ob >> 9) & 1) << 5)); }
__host__ __device__ __forceinline__ void stage_rc(int b, int& R, int& C) { const int st = b / 1024, sb = b % 1024, swz = sb ^ (((sb >> 9) & 1) << 5); R = (st >> 1) * 16 + swz / 64; C = (st & 1) * 32 + (swz % 64) / 2; }
__host__ __device__ __forceinline__ int perm32(int rho) { const int n = rho >> 4, i = rho & 15; return 8 * (i >> 2) + 4 * n + (i & 3); }

struct Unit { int pm, pn; };
struct Gemm { const bf16_t* A; const bf16_t* Bt; int M, N, K; };

struct StaticOrder {
    int nM, nN, nwg, G, c, wgm;
    __host__ __device__ void init(int M, int N, int G_, int c_, int wgm_ = WGM) { nM = M / BM; nN = N / BM; nwg = nM * nN; G = G_; c = c_; wgm = wgm_; }
    __host__ __device__ bool next(int i, Unit& u) const {
        const long L = (long)i * G + c; if (L >= nwg) return false;
        int wgid = (int)L; { const int q = nwg / NXCD, r = nwg % NXCD, xcd = wgid % NXCD, off = wgid / NXCD; wgid = (xcd < r ? xcd * (q + 1) : r * (q + 1) + (xcd - r) * q) + off; }
        const int nig = wgm * nN, gid = wgid / nig, fm = gid * wgm, gsz = (nM - fm) < wgm ? (nM - fm) : wgm;
        u.pm = fm + ((wgid % nig) % gsz); u.pn = (wgid % nig) / gsz; return true;
    }
    __device__ __forceinline__ void a_ready(const Unit&) const {}
    __device__ __forceinline__ void done(const Unit&) const {}
};

__device__ __forceinline__ unsigned cvt_pk_bf16(float lo, float hi) { unsigned r; asm volatile("v_cvt_pk_bf16_f32 %0, %1, %2" : "=v"(r) : "v"(lo), "v"(hi)); return r; }
typedef float f32x2 __attribute__((ext_vector_type(2)));
__device__ __forceinline__ f32x2 gelu_pk(f32x2 v) {
    const f32x2 av = __builtin_elementwise_abs(v), d = av * 0.2316418882f + 1.0f;
    f32x2 t; t.x = __builtin_amdgcn_rcpf(d.x); t.y = __builtin_amdgcn_rcpf(d.y);
    f32x2 q = t * 0.5307027145f + (-0.7265760135f); q = q * t + 0.7107068705f; q = q * t + (-0.142248368f); q = q * t + 0.127414796f; q = q * t;
    const f32x2 s = (v * v) * (-0.72134752044f);
    f32x2 e; e.x = __builtin_amdgcn_exp2f(s.x); e.y = __builtin_amdgcn_exp2f(s.y);
    const f32x2 m = v * (q * e), r = v - m;
    f32x2 o; o.x = v.x < 0.f ? m.x : r.x; o.y = v.y < 0.f ? m.y : r.y; return o;
}

template <int ACT  > struct EpiBf16 {
    static constexpr bool PERM = true, AFTER_DRAIN = false; static_assert(ACT == 0 || ACT == 1 || ACT == 2, "EpiBf16: ACT is 0 (none), 1 (gelu_pk) or 2 (squared relu)");
    bf16_t* O; int ldc; const float* bias; int split_cols; size_t split_stride; float scale0;
    __device__ __forceinline__ void operator()(const f32x4 (&acc)[2][2][4][2], const Unit& u, int wr, int wc, int fr, int fq) const {
        const int row0 = u.pm * BM + wr * 64 + fr; int colt = u.pn * BM; bf16_t* base = O;
        float sc = 1.f; if (split_cols) { const int t = colt / split_cols; base += (size_t)t * split_stride; colt -= t * split_cols; if (t == 0) sc = scale0; }
        const int col0 = colt + wc * 32 + 8 * fq, bcol0 = u.pn * BM + wc * 32 + 8 * fq;
        f32x4 bv[2][2];
#pragma unroll
        for (int bj = 0; bj < 2; ++bj)
#pragma unroll
            for (int n = 0; n < 2; ++n) bv[bj][n] = bias ? *(const f32x4*)(bias + bcol0 + bj * HALF + 4 * n) : (f32x4){0.f, 0.f, 0.f, 0.f};
#pragma unroll
        for (int ai = 0; ai < 2; ++ai)
#pragma unroll
            for (int m = 0; m < 4; ++m) { bf16_t* rowp = base + (size_t)(row0 + ai * HALF + m * 16) * ldc + col0;
#pragma unroll
                for (int bj = 0; bj < 2; ++bj) { f32x4 v0 = acc[ai][bj][m][0] + bv[bj][0], v1 = acc[ai][bj][m][1] + bv[bj][1];
                    if (ACT == 1) { f32x2 a = gelu_pk((f32x2){v0[0], v0[1]}), b = gelu_pk((f32x2){v0[2], v0[3]}), c = gelu_pk((f32x2){v1[0], v1[1]}), d = gelu_pk((f32x2){v1[2], v1[3]});
                        v0 = (f32x4){a.x, a.y, b.x, b.y}; v1 = (f32x4){c.x, c.y, d.x, d.y}; }
                    if (ACT == 2) { v0 = __builtin_elementwise_max(v0, (f32x4){0.f, 0.f, 0.f, 0.f}); v1 = __builtin_elementwise_max(v1, (f32x4){0.f, 0.f, 0.f, 0.f}); v0 = v0 * v0; v1 = v1 * v1; }
                    v0 = v0 * sc; v1 = v1 * sc; u32x4 w; w.x = cvt_pk_bf16(v0[0], v0[1]); w.y = cvt_pk_bf16(v0[2], v0[3]); w.z = cvt_pk_bf16(v1[0], v1[1]); w.w = cvt_pk_bf16(v1[2], v1[3]);
                    *(u32x4*)(rowp + bj * HALF) = w; } }
    }
};

struct EpiResF32 {
    static constexpr bool PERM = false, AFTER_DRAIN = false;
    const float* base; float* out; int ldc; float sc;
    __device__ __forceinline__ void operator()(const f32x4 (&acc)[2][2][4][2], const Unit& u, int wr, int wc, int fr, int fq) const {
        const int col0 = u.pn * BM + wc * 32 + 4 * fq;
#pragma unroll
        for (int ai = 0; ai < 2; ++ai)
#pragma unroll
            for (int m = 0; m < 4; ++m) { const size_t off = (size_t)(u.pm * BM + ai * HALF + wr * 64 + m * 16 + fr) * ldc + col0;
                f32x4 bs[2][2];
#pragma unroll
                for (int bj = 0; bj < 2; ++bj)
#pragma unroll
                    for (int n = 0; n < 2; ++n) bs[bj][n] = *(const f32x4*)(base + off + bj * HALF + n * 16);
#pragma unroll
                for (int bj = 0; bj < 2; ++bj)
#pragma unroll
                    for (int n = 0; n < 2; ++n) *(f32x4*)(out + off + bj * HALF + n * 16) = bs[bj][n] + acc[ai][bj][m][n] * sc;
            }
    }
};
struct EpiNull {
    static constexpr bool PERM = false, AFTER_DRAIN = false;
    __device__ __forceinline__ void operator()(const f32x4 (&acc)[2][2][4][2], const Unit& u, int wr, int wc, int fr, int fq) const {
        f32x4 s = {0.f, 0.f, 0.f, 0.f};
#pragma unroll
        for (int ai = 0; ai < 2; ++ai)
#pragma unroll
            for (int bj = 0; bj < 2; ++bj)
#pragma unroll
                for (int m = 0; m < 4; ++m)
#pragma unroll
                    for (int n = 0; n < 2; ++n) s += acc[ai][bj][m][n];
        asm volatile("" :: "v"(s));
    }
};

struct EpiQKVn {
    static constexpr bool PERM = true, AFTER_DRAIN = false;
    bf16_t* O; int ldc; size_t split_stride; float* ksq; int seq;
    __device__ __forceinline__ void operator()(const f32x4 (&acc)[2][2][4][2], const Unit& u, int wr, int wc, int fr, int fq) const {
        const int row0 = u.pm * BM + wr * 64 + fr; int colt = u.pn * BM; const int t = colt / ldc; colt -= t * ldc;
        bf16_t* base = O + (size_t)t * split_stride; const int col0 = colt + wc * 32 + 8 * fq;
        const int lane = fr + 16 * fq;
#pragma unroll
        for (int ai = 0; ai < 2; ++ai)
#pragma unroll
            for (int m = 0; m < 4; ++m) { const int row = row0 + ai * HALF + m * 16; bf16_t* rowp = base + (size_t)row * ldc + col0;
#pragma unroll
                for (int bj = 0; bj < 2; ++bj) { const f32x4 v0 = acc[ai][bj][m][0], v1 = acc[ai][bj][m][1];
                    u32x4 w; w.x = cvt_pk_bf16(v0[0], v0[1]); w.y = cvt_pk_bf16(v0[2], v0[3]); w.z = cvt_pk_bf16(v1[0], v1[1]); w.w = cvt_pk_bf16(v1[2], v1[3]);
                    *(u32x4*)(rowp + bj * HALF) = w;
                    if (t == 1) {
                        float sq = (v0[0] * v0[0] + v0[1] * v0[1]) + (v0[2] * v0[2] + v0[3] * v0[3]) + (v1[0] * v1[0] + v1[1] * v1[1]) + (v1[2] * v1[2] + v1[3] * v1[3]);
                        sq += __builtin_bit_cast(float, __builtin_amdgcn_ds_bpermute((lane ^ 16) << 2, __builtin_bit_cast(int, sq)));
                        sq += __builtin_bit_cast(float, __builtin_amdgcn_ds_bpermute((lane ^ 32) << 2, __builtin_bit_cast(int, sq)));
                        if (fq == 0) { const int b = row / seq, head = (colt >> 7) + bj; atomicAdd(ksq + ((size_t)(b * 8 + head) * seq + (row - b * seq)), sq); }
                    } } }
    }
};
template <class Epi, class Sched, bool ALIGN_EPI = false, bool SP2 = false>
__device__ __forceinline__ void gemm_phase(PG8_LAS unsigned char* lds, const Gemm g, const Sched& S, const Epi& E, const int wave_u) {
    int tid = wave_u * 64 + fresh_lane(); asm volatile("" : "+v"(tid));
    const int wid = __builtin_amdgcn_readfirstlane(tid >> 6), lane = tid & 63, wr = wid >> 2, wc = wid & 3, fr = lane & 15, fq = lane >> 4;
    const int K = g.K, nt = K / BK;
    unsigned voffA[2], voffB[2];
#pragma unroll
    for (int i = 0; i < 2; ++i) { int R, C; stage_rc(tid * 16 + i * 8192, R, C); const int Rb = Epi::PERM ? ((R & ~31) + perm32(R & 31)) : R;
        voffA[i] = (unsigned)(R * K + C) * 2u; voffB[i] = (unsigned)(Rb * K + C) * 2u; }
    const size_t kstep = (size_t)(BK * 2);
    const size_t hstep = (size_t)HALF * K * 2;
    const size_t tstep = 2 * hstep;
    const unsigned ldsw = (unsigned)wid * 1024u;
    const int aoff = lds_byte(wr * 64 + fr, fq * 8), boff = lds_byte(wc * 32 + fr, fq * 8);
#define PG8_SA(b, h) (((b) * 2 + (h)) * HTB)
#define PG8_SB(b, h) ((4 + (b) * 2 + (h)) * HTB)
#define PG8_STAGE(bufoff, gbase, voff) do { _Pragma("unroll") for (int _i = 0; _i < 2; ++_i) \
        __builtin_amdgcn_global_load_lds((const unsigned*)((const char*)(gbase) + (voff)[_i]), (PG8_LAS unsigned*)(lds + (bufoff) + ldsw + _i * 8192), 16, 0, 0); } while (0)
#define PG8_LDA(dst, b, h) do { _Pragma("unroll") for (int m = 0; m < 4; ++m) _Pragma("unroll") for (int k = 0; k < 2; ++k) dst[m][k] = *(const PG8_LAS bf16x8*)(lds + PG8_SA(b, h) + aoff + m * 2048 + k * 1024); } while (0)
#define PG8_LDB(dst, b, h) do { _Pragma("unroll") for (int n = 0; n < 2; ++n) _Pragma("unroll") for (int k = 0; k < 2; ++k) dst[n][k] = *(const PG8_LAS bf16x8*)(lds + PG8_SB(b, h) + boff + n * 2048 + k * 1024); } while (0)
#define PG8_MMA(ai, bj, At, Bt) do { __builtin_amdgcn_s_setprio(1); _Pragma("unroll") for (int m = 0; m < 4; ++m) _Pragma("unroll") for (int n = 0; n < 2; ++n) _Pragma("unroll") for (int k = 0; k < 2; ++k) \
        acc[ai][bj][m][n] = __builtin_amdgcn_mfma_f32_16x16x32_bf16(Bt[n][k], At[m][k], acc[ai][bj][m][n], 0, 0, 0); __builtin_amdgcn_s_setprio(0); } while (0)
#define PG8_WAIT_V(n) asm volatile("s_waitcnt vmcnt(" #n ")" ::: "memory")
#define PG8_WAIT_L(n) asm volatile("s_waitcnt lgkmcnt(" #n ")" ::: "memory")
#define PG8_BAR __builtin_amdgcn_s_barrier()
#define PG8_SCHED __builtin_amdgcn_sched_barrier(0)
    Unit cur, nxt; int ui = 0;
    if (!S.next(0, cur)) return;
    f32x4 acc[2][2][4][2];
#pragma unroll
    for (int a = 0; a < 2; ++a)
#pragma unroll
        for (int b = 0; b < 2; ++b)
#pragma unroll
            for (int m = 0; m < 4; ++m)
#pragma unroll
                for (int n = 0; n < 2; ++n) acc[a][b][m][n] = (f32x4){0.f, 0.f, 0.f, 0.f};
    bf16x8 At[4][2], B0[2][2], B1[2][2];
    const char* cA = (const char*)g.A + (size_t)cur.pm * tstep; const char* cB = (const char*)g.Bt + (size_t)cur.pn * tstep;
    S.a_ready(cur);
    if constexpr (SP2) {
        PG8_STAGE(PG8_SB(0, 0), cB, voffB); PG8_STAGE(PG8_SB(0, 1), cB + hstep, voffB); PG8_STAGE(PG8_SA(0, 0), cA, voffA); PG8_STAGE(PG8_SA(0, 1), cA + hstep, voffA);
        if (wr == 1) PG8_BAR;
        PG8_WAIT_V(2); PG8_BAR;
        PG8_STAGE(PG8_SB(1, 0), cB + kstep, voffB); PG8_STAGE(PG8_SA(1, 0), cA + kstep, voffA); PG8_STAGE(PG8_SB(1, 1), cB + hstep + kstep, voffB);
        PG8_WAIT_V(6); PG8_BAR;
    } else {
        PG8_STAGE(PG8_SB(0, 0), cB, voffB); PG8_STAGE(PG8_SA(0, 0), cA, voffA); PG8_STAGE(PG8_SB(0, 1), cB + hstep, voffB); PG8_STAGE(PG8_SA(0, 1), cA + hstep, voffA);
        if (wr == 1) PG8_BAR;
        PG8_WAIT_V(4); PG8_BAR;
        PG8_STAGE(PG8_SB(1, 0), cB + kstep, voffB); PG8_STAGE(PG8_SA(1, 0), cA + kstep, voffA); PG8_STAGE(PG8_SB(1, 1), cB + hstep + kstep, voffB);
        PG8_WAIT_V(6); PG8_BAR;
    }
    for (;;) {
        const bool has_next = S.next(ui + 1, nxt);
        const char* nA = has_next ? (const char*)g.A + (size_t)nxt.pm * tstep : cA; const char* nB = has_next ? (const char*)g.Bt + (size_t)nxt.pn * tstep : cB;
        for (int t = 0; t < nt; t += 2) {
            const bool last = (t == nt - 2);
            const char* a1 = cA + (size_t)(t + 1) * kstep;
            const char* a2 = last ? nA : cA + (size_t)(t + 2) * kstep; const char* b2 = last ? nB : cB + (size_t)(t + 2) * kstep;
            const char* a3 = a2 + kstep; const char* b3 = b2 + kstep;
            if (last && has_next) S.a_ready(nxt);
            if constexpr (SP2) {
            PG8_LDB(B0, 0, 0); PG8_LDB(B1, 0, 1); PG8_SCHED; PG8_LDA(At, 0, 0); PG8_STAGE(PG8_SA(1, 1), a1 + hstep, voffA);
            PG8_WAIT_V(8); PG8_WAIT_L(0); PG8_BAR; PG8_MMA(0, 0, At, B0); PG8_MMA(0, 1, At, B1); PG8_BAR; PG8_SCHED;
            PG8_LDA(At, 0, 1); PG8_STAGE(PG8_SB(0, 0), b2, voffB); PG8_STAGE(PG8_SB(0, 1), b2 + hstep, voffB); PG8_STAGE(PG8_SA(0, 0), a2, voffA);
            PG8_WAIT_V(8); PG8_WAIT_L(0); PG8_BAR; PG8_MMA(1, 0, At, B0); PG8_MMA(1, 1, At, B1); PG8_BAR; PG8_SCHED;
            PG8_LDB(B0, 1, 0); PG8_LDB(B1, 1, 1); PG8_SCHED; PG8_LDA(At, 1, 0); PG8_STAGE(PG8_SA(0, 1), a2 + hstep, voffA);
            PG8_WAIT_V(8); PG8_WAIT_L(0); PG8_BAR; PG8_MMA(0, 0, At, B0); PG8_MMA(0, 1, At, B1); PG8_BAR; PG8_SCHED;
            PG8_LDA(At, 1, 1); PG8_STAGE(PG8_SB(1, 0), b3, voffB); PG8_STAGE(PG8_SB(1, 1), b3 + hstep, voffB); PG8_STAGE(PG8_SA(1, 0), a3, voffA);
            PG8_WAIT_V(8); PG8_WAIT_L(0); PG8_BAR; PG8_MMA(1, 0, At, B0); PG8_MMA(1, 1, At, B1); PG8_BAR; PG8_SCHED;
            } else {
            PG8_LDB(B0, 0, 0); PG8_SCHED; PG8_LDA(At, 0, 0); PG8_STAGE(PG8_SA(1, 1), a1 + hstep, voffA);
            PG8_WAIT_L(8); PG8_BAR; PG8_WAIT_L(0); PG8_MMA(0, 0, At, B0); PG8_BAR; PG8_SCHED;
            PG8_LDB(B1, 0, 1); PG8_STAGE(PG8_SB(0, 0), b2, voffB);
            PG8_BAR; PG8_WAIT_L(0); PG8_MMA(0, 1, At, B1); PG8_BAR;
            PG8_LDA(At, 0, 1); PG8_STAGE(PG8_SA(0, 0), a2, voffA);
            PG8_BAR; PG8_WAIT_L(0); PG8_MMA(1, 0, At, B0); PG8_BAR; PG8_SCHED;
            PG8_STAGE(PG8_SB(0, 1), b2 + hstep, voffB);
            PG8_WAIT_V(6); PG8_BAR; PG8_MMA(1, 1, At, B1); PG8_BAR;
            PG8_LDB(B0, 1, 0); PG8_SCHED; PG8_LDA(At, 1, 0); PG8_STAGE(PG8_SA(0, 1), a2 + hstep, voffA);
            PG8_WAIT_L(8); PG8_BAR; PG8_WAIT_L(0); PG8_MMA(0, 0, At, B0); PG8_BAR; PG8_SCHED;
            PG8_LDB(B1, 1, 1); PG8_STAGE(PG8_SB(1, 0), b3, voffB);
            PG8_BAR; PG8_WAIT_L(0); PG8_MMA(0, 1, At, B1); PG8_BAR;
            PG8_LDA(At, 1, 1); PG8_STAGE(PG8_SA(1, 0), a3, voffA);
            PG8_BAR; PG8_WAIT_L(0); PG8_MMA(1, 0, At, B0); PG8_BAR; PG8_SCHED;
            PG8_STAGE(PG8_SB(1, 1), b3 + hstep, voffB);
            PG8_WAIT_V(6); PG8_BAR; PG8_MMA(1, 1, At, B1); PG8_BAR;
            }
        }
        if constexpr (ALIGN_EPI) { if (wr == 0) PG8_BAR; }
        if constexpr (!Epi::AFTER_DRAIN) { E(acc, cur, wr, wc, fr, fq); S.done(cur); }
        if (!has_next) break;
#pragma unroll
        for (int a = 0; a < 2; ++a)
#pragma unroll
            for (int b = 0; b < 2; ++b)
#pragma unroll
                for (int m = 0; m < 4; ++m)
#pragma unroll
                    for (int n = 0; n < 2; ++n) acc[a][b][m][n] = (f32x4){0.f, 0.f, 0.f, 0.f};
        cur = nxt; cA = nA; cB = nB; ++ui;
        if constexpr (ALIGN_EPI) { if (wr == 1) PG8_BAR; }
    }
    PG8_WAIT_V(0);
    if constexpr (!ALIGN_EPI) { if (wr == 0) PG8_BAR; }
    PG8_BAR;
    if constexpr (Epi::AFTER_DRAIN) { E.fused(acc, cur, wr, wc, fr, fq, lds, wid, lane); S.done(cur); }
#undef PG8_SA
#undef PG8_SB
#undef PG8_STAGE
#undef PG8_LDA
#undef PG8_LDB
#undef PG8_MMA
#undef PG8_WAIT_V
#undef PG8_WAIT_L
#undef PG8_BAR
#undef PG8_SCHED
}
}
namespace swa {
constexpr int D = 128;
constexpr float THR = 8.f;
constexpr float SCALE = 0.08838834764831845f;
constexpr int NW = 8, QBLK = 32, KVBLK = 64, QB = NW * QBLK;
constexpr int SHM_V = KVBLK * D * 2, SHM_K = KVBLK * D * 2;
constexpr int NVS = 3;
constexpr int OFF_WS = NVS * SHM_V + 2 * SHM_K;
constexpr int OFF_CS = OFF_WS + NW * 64 * 4;
constexpr int OFF_SC = OFF_CS + 4096 * 8;
constexpr int LDS_BYTES = OFF_SC + 128;
constexpr int TABN = 320, TABOFF = 96;
#ifndef PIPE2
#define PIPE2 0
#endif

using bf16 = __hip_bfloat16;
typedef short bf16x8 __attribute__((ext_vector_type(8)));
typedef short s16x4 __attribute__((ext_vector_type(4)));
typedef float f32x16 __attribute__((ext_vector_type(16)));
typedef float f32x4 __attribute__((ext_vector_type(4)));
typedef unsigned u32x4 __attribute__((ext_vector_type(4)));
typedef unsigned u32x2 __attribute__((ext_vector_type(2)));

#define KSWZ(row, colB) ((row) * 256 + ((colB) ^ (((row) & 7) << 4)))
#define SBAR() __builtin_amdgcn_sched_barrier(0)
__device__ __forceinline__ int v_st(int k, int c) { const int kk = (k & ~0xC) | ((k & 4) << 1) | ((k & 8) >> 1); return ((kk >> 3) * 4 + (c >> 5)) * 512 + ((kk & 7) * 32 + (c & 31)) * 2; }
__device__ __forceinline__ int v_rd_base(int lane) { return ((lane & 3) << 3) | (((lane >> 2) & 3) << 6) | (((lane >> 4) & 1) << 5) | (((lane >> 5) & 1) << 8); }
constexpr int v_rd_off(int d0, int ks, int half) { return d0 * 512 + ks * 4096 + half * 2048; }
__device__ __forceinline__ int crow(int r, int hi) { return (r & 3) + 8 * (r >> 2) + 4 * hi; }
__device__ __forceinline__ unsigned cvtpk(float lo, float hi) { unsigned r; asm volatile("v_cvt_pk_bf16_f32 %0, %1, %2" : "=v"(r) : "v"(lo), "v"(hi)); return r; }
__device__ __forceinline__ bf16x8 load8(const bf16* p) { return *reinterpret_cast<const bf16x8*>(p); }

__device__ __forceinline__ void mask_tile(f32x16& p0, f32x16& p1, int dq, unsigned W) {
    const float NEG = -__builtin_inff();
#pragma unroll
    for (int r = 0; r < 16; ++r) {
        const int c = (r & 3) + 8 * (r >> 2);
        if ((unsigned)(dq - c) >= W) p0[r] = NEG;
        if ((unsigned)(dq - c - 32) >= W) p1[r] = NEG;
    }
}
__device__ __forceinline__ void bias_mask_tile(f32x16& p0, f32x16& p1, int dq, unsigned W, const float* tab) {
    const float NEG = -__builtin_inff();
    const float* tb = tab + TABOFF + dq;
#pragma unroll
    for (int q = 0; q < 4; ++q) {
#pragma unroll
        for (int e = 0; e < 4; ++e) { const int r = 4 * q + e, c = e + 8 * q;
            const float b0 = tb[-c], b1 = tb[-c - 32];
            p0[r] = ((unsigned)(dq - c) >= W) ? NEG : p0[r] + b0;
            p1[r] = ((unsigned)(dq - c - 32) >= W) ? NEG : p1[r] + b1; }
        asm volatile("" ::: "memory");
    }
}
__device__ __forceinline__ void partialSM(f32x16& p0, f32x16& p1, float& m_reg, float& mn, float& alpha) {
    float pmax = p0[0]; for (int r = 1; r < 16; ++r) pmax = fmaxf(pmax, p0[r]); for (int r = 0; r < 16; ++r) pmax = fmaxf(pmax, p1[r]);
    { auto rr = __builtin_amdgcn_permlane32_swap(__float_as_uint(pmax), __float_as_uint(pmax), false, false);
      pmax = fmaxf(__uint_as_float(rr[0]), __uint_as_float(rr[1])); }
    constexpr float C2 = 1.4426950408889634f * SCALE;
    if (__builtin_expect(__all((pmax - m_reg) * SCALE <= THR), 1)) { mn = m_reg; alpha = 1.f; }
    else { mn = fmaxf(m_reg, pmax); alpha = __builtin_amdgcn_exp2f((m_reg - mn) * C2); m_reg = mn; }
    const float mnL = -mn * C2;
    for (int r = 0; r < 16; ++r) p0[r] = fmaf(p0[r], C2, mnL); for (int r = 0; r < 16; ++r) p1[r] = fmaf(p1[r], C2, mnL);
    for (int r = 0; r < 16; ++r) p0[r] = __builtin_amdgcn_exp2f(p0[r]);
}
__device__ __forceinline__ void finishSM(f32x16& p0, f32x16& p1, float alpha, float& l_reg, bf16x8& pa0, bf16x8& pa1, bf16x8& pa2, bf16x8& pa3) {
    for (int r = 0; r < 16; ++r) p1[r] = __builtin_amdgcn_exp2f(p1[r]);
    float ps = 0; for (int r = 0; r < 16; ++r) ps += p0[r]; for (int r = 0; r < 16; ++r) ps += p1[r];
    { auto rr = __builtin_amdgcn_permlane32_swap(__float_as_uint(ps), __float_as_uint(ps), false, false);
      ps = __uint_as_float(rr[0]) + __uint_as_float(rr[1]); }
    l_reg = l_reg * alpha + ps;
#define PK4(P, B_, OUT) do { unsigned a0 = cvtpk(P[B_+0], P[B_+1]), a1 = cvtpk(P[B_+2], P[B_+3]);                          \
        unsigned b0 = cvtpk(P[B_+4], P[B_+5]), b1 = cvtpk(P[B_+6], P[B_+7]);                                             \
        auto r0 = __builtin_amdgcn_permlane32_swap(a0, b0, false, false); auto r1 = __builtin_amdgcn_permlane32_swap(a1, b1, false, false); \
        u32x4 w = {r0[0], r1[0], r0[1], r1[1]}; OUT = *reinterpret_cast<bf16x8*>(&w); } while (0)
    PK4(p0, 0, pa0); PK4(p0, 8, pa1); PK4(p1, 0, pa2); PK4(p1, 8, pa3);
#undef PK4
}
#define KRD(dst, base, off) asm volatile("ds_read_b128 %0, %1 offset:%2" : "=&v"(dst) : "v"(base), "i"(off) : "memory")
#define SB_ALU() __builtin_amdgcn_sched_barrier(0)
template <int KB, bool SK, int MODE>
__device__ __forceinline__ void qkt(f32x16& p0, f32x16& p1, const int* kba, int r32, int hi, const bf16x8* qr, bool act, const unsigned long long* csk, const unsigned long long* csq) {
    if (SK && !act) { const float NEG = -__builtin_inff();
#pragma unroll
        for (int r = 0; r < 16; ++r) { p0[r] = NEG; p1[r] = NEG; } return; }
    constexpr int OB = KB * SHM_K;
    bf16x8 a0, a1, b0, b1;
    KRD(a0, kba[0], OB); KRD(a1, kba[0], OB + 8192); KRD(b0, kba[1], OB); KRD(b1, kba[1], OB + 8192);
    p0 = f32x16{}; p1 = f32x16{};
    if constexpr (MODE == 1) {
        const u32x2 t0 = *(const u32x2*)(csk), t1 = *(const u32x2*)(csk + 32), tq = *(const u32x2*)(csq);
        const u32x4 qv = {0x3f803f80u, 0x00003f80u, tq.x ^ 0x80008000u, tq.y ^ 0x00008000u};
        const bf16x8 qx = hi ? bf16x8{} : __builtin_bit_cast(bf16x8, qv);
        const u32x4 k0 = {t0.x, t0.y, 0x3f803f80u, 0x00003f80u}, k1 = {t1.x, t1.y, 0x3f803f80u, 0x00003f80u};
        p0 = __builtin_amdgcn_mfma_f32_32x32x16_bf16(__builtin_bit_cast(bf16x8, k0), qx, p0, 0, 0, 0);
        p1 = __builtin_amdgcn_mfma_f32_32x32x16_bf16(__builtin_bit_cast(bf16x8, k1), qx, p1, 0, 0, 0);
    }
#define QK_STEP(X0, X1, d0, NB, LD0) do { asm volatile("s_waitcnt lgkmcnt(%0)" :: "i"(NB) : "memory"); SB_ALU(); \
        p0 = __builtin_amdgcn_mfma_f32_32x32x16_bf16(X0, qr[d0], p0, 0, 0, 0); p1 = __builtin_amdgcn_mfma_f32_32x32x16_bf16(X1, qr[d0], p1, 0, 0, 0); SB_ALU(); \
        if (LD0 < 8) { KRD(X0, kba[(LD0) & 3], OB + ((LD0) >> 2) * 128); KRD(X1, kba[(LD0) & 3], OB + ((LD0) >> 2) * 128 + 8192); } } while (0)
    __builtin_amdgcn_s_setprio(1);
    QK_STEP(a0, a1, 0, 2, 2); QK_STEP(b0, b1, 1, 2, 3); QK_STEP(a0, a1, 2, 2, 4); QK_STEP(b0, b1, 3, 2, 5);
    QK_STEP(a0, a1, 4, 2, 6); QK_STEP(b0, b1, 5, 2, 7); QK_STEP(a0, a1, 6, 2, 8); QK_STEP(b0, b1, 7, 0, 9);
    __builtin_amdgcn_s_setprio(0);
#undef QK_STEP
}
template <int VB, bool SK>
__device__ __forceinline__ void pv_tile(f32x16* o, int vb0, bf16x8 pa0, bf16x8 pa1, bf16x8 pa2, bf16x8 pa3, bool act) {
    if (SK && !act) return;
#define TRRD(dst, off) asm volatile("ds_read_b64_tr_b16 %0, %1 offset:%2" : "=&v"(dst) : "v"(vb0), "i"(off) : "memory")
#define PV_D0(d0) do { s16x4 l0, l1, l2, l3, h0, h1, h2, h3; constexpr int b_ = VB * SHM_V + v_rd_off(d0, 0, 0); \
        TRRD(l0, b_); TRRD(h0, b_ + 2048); TRRD(l1, b_ + 4096); TRRD(h1, b_ + 6144); TRRD(l2, b_ + 8192); TRRD(h2, b_ + 10240); TRRD(l3, b_ + 12288); TRRD(h3, b_ + 14336); \
        asm volatile("s_waitcnt lgkmcnt(0)" ::: "memory"); SBAR();   \
        o[d0] = __builtin_amdgcn_mfma_f32_32x32x16_bf16(pa0, (bf16x8){l0[0], l0[1], l0[2], l0[3], h0[0], h0[1], h0[2], h0[3]}, o[d0], 0, 0, 0);   \
        o[d0] = __builtin_amdgcn_mfma_f32_32x32x16_bf16(pa1, (bf16x8){l1[0], l1[1], l1[2], l1[3], h1[0], h1[1], h1[2], h1[3]}, o[d0], 0, 0, 0);   \
        o[d0] = __builtin_amdgcn_mfma_f32_32x32x16_bf16(pa2, (bf16x8){l2[0], l2[1], l2[2], l2[3], h2[0], h2[1], h2[2], h2[3]}, o[d0], 0, 0, 0);   \
        o[d0] = __builtin_amdgcn_mfma_f32_32x32x16_bf16(pa3, (bf16x8){l3[0], l3[1], l3[2], l3[3], h3[0], h3[1], h3[2], h3[3]}, o[d0], 0, 0, 0); } while (0)
    __builtin_amdgcn_s_setprio(1); PV_D0(0); PV_D0(1); PV_D0(2); PV_D0(3); __builtin_amdgcn_s_setprio(0);
#undef PV_D0
#undef TRRD
}

struct BlockRef { const bf16* Q; const bf16* K; const bf16* V; bf16* O; float* L; const float* aux; const float* aux2; int P0, skv, W, pad; };
__device__ __forceinline__ int swa_jlo(int P0, int W) { const int lowk = P0 - W + 1; return lowk > 0 ? lowk / KVBLK : 0; }
#define ROW(p, k0, rr0, rs_) ((const bf16*)((const char*)(p) + (size_t)((k0) + (rr0)) * (size_t)(rs_) * 2 + voff))
#define VMW() asm volatile("s_waitcnt vmcnt(0)" ::: "memory")
#define SLOAD_H(Kp, Vp, k0, rs_) do { st_v0 = load8(ROW(Vp, k0, 0, rs_)); st_v1 = load8(ROW(Vp, k0, 32, rs_));              \
                         st_k0 = load8(ROW(Kp, k0, 0, rs_)); st_k1 = load8(ROW(Kp, k0, 32, rs_)); } while (0)
#define SWRITE_HK(bf) do { *(bf16x8*)(K_lds + (bf) * SHM_K + kws) = st_k0; *(bf16x8*)(K_lds + (bf) * SHM_K + kws + 32 * 256) = st_k1; } while (0)
#define SWRITE_HV(off_) do { *(bf16x8*)(V_lds + (off_) + vst0) = st_v0; *(bf16x8*)(V_lds + (off_) + vst1) = st_v1; } while (0)
template <int MODE, bool SK, int RS>
__device__ __forceinline__ void swa_block(const BlockRef& cur, char* lds, const int wave_u) {
    int tid = wave_u * 64 + fresh_lane(); asm volatile("" : "+v"(tid));
    const int wid = __builtin_amdgcn_readfirstlane(tid >> 6), lane = tid & 63, r32 = lane & 31, hi = lane >> 5;
    const int W = cur.W, skv = cur.skv; constexpr int rs = RS;
    int j_lo = swa_jlo(cur.P0, W), jw_lo = 0;
    int j_hi = (cur.P0 + QB - 1) / KVBLK + 1; if (j_hi > skv / KVBLK) j_hi = skv / KVBLK;
    const int qlo = cur.P0 + wid * QBLK, qm = qlo + r32 - 4 * hi;
    char* V_lds = lds; char* K_lds = lds + NVS * SHM_V;
    float* ws = (float*)(lds + OFF_WS) + wid * 64; float* li_l = ws, * al_l = ws + 32;
    const int sr = tid >> 4, sc = (tid & 15) * 8, vst0 = v_st(sr, sc), vst1 = v_st(32 + sr, sc), kws = KSWZ(sr, sc * 2);
    const unsigned voff = (unsigned)(sr * RS + sc) * 2u, qoff = (unsigned)(r32 * RS + hi * 8) * 2u;
    const int vb0 = (int)(uintptr_t)V_lds + v_rd_base(lane);
    int kba[4];
#pragma unroll
    for (int dd = 0; dd < 4; ++dd) kba[dd] = (int)(uintptr_t)K_lds + KSWZ(r32, (dd * 16 + hi * 8) * 2);
    const bf16* Kh = cur.K; const bf16* Vh = cur.V;
    bf16x8 qr[8], st_v0, st_v1, st_k0, st_k1;
#define KBASE(t) ((j_lo + (t)) * KVBLK)
    { const char* qb_ = (const char*)(cur.Q + (size_t)(cur.P0 + wid * QBLK) * RS);
#pragma unroll
      for (int d0 = 0; d0 < 8; ++d0) qr[d0] = load8((const bf16*)(qb_ + qoff + d0 * 32)); }
    if constexpr (MODE != 1) { SLOAD_H(Kh, Vh, KBASE(0), RS); }
    unsigned long long* cs = (unsigned long long*)(lds + OFF_CS);
    if constexpr (MODE == 1) {
        float* sc8 = (float*)(lds + OFF_SC);
        const int n = cur.P0 + QB; const float* lf = cur.aux;
        f32x4 a = {0.f, 0.f, 0.f, 0.f}, b = {0.f, 0.f, 0.f, 0.f};
        if (8 * tid < n) { a = *(const f32x4*)(lf + 8 * tid); b = *(const f32x4*)(lf + 8 * tid + 4); }
        a[1] += a[0]; a[2] += a[1]; a[3] += a[2]; b[0] += a[3]; b[1] += b[0]; b[2] += b[1]; b[3] += b[2];
        const float tot = b[3]; float inc = tot;
#pragma unroll
        for (int o_ = 1; o_ < 64; o_ <<= 1) { const float v = __builtin_bit_cast(float, __builtin_amdgcn_ds_bpermute((lane - o_) << 2, __builtin_bit_cast(int, inc))); if (lane >= o_) inc += v; }
        if (lane == 63) sc8[wid] = inc;
        __syncthreads();
        float base = inc - tot;
        for (int w = 0; w < wid; ++w) base += sc8[w];
        const float ninv = -1.f / SCALE;
        if (8 * tid < n) {
#pragma unroll
            for (int e = 0; e < 8; ++e) { const float v = ((e < 4 ? a[e & 3] : b[e & 3]) + base) * ninv;
                const unsigned h = cvtpk(v, 0.f) & 0xffffu; const float r1 = v - __uint_as_float(h << 16);
                const unsigned m = cvtpk(r1, 0.f) & 0xffffu; const float r2 = r1 - __uint_as_float(m << 16);
                const unsigned lo = cvtpk(r2, 0.f) & 0xffffu;
                cs[8 * tid + e] = (unsigned long long)(h | (m << 16)) | ((unsigned long long)lo << 32); }
        }
        float kmx = 0.f;
        if (8 * tid < n) { const f32x4 ka = *(const f32x4*)(cur.aux2 + 8 * tid), kb2 = *(const f32x4*)(cur.aux2 + 8 * tid + 4);
            kmx = fmaxf(fmaxf(fmaxf(ka[0], ka[1]), fmaxf(ka[2], ka[3])), fmaxf(fmaxf(kb2[0], kb2[1]), fmaxf(kb2[2], kb2[3]))); }
        float qsq = 0.f;
#pragma unroll
        for (int d0 = 0; d0 < 8; ++d0)
#pragma unroll
            for (int e = 0; e < 8; ++e) { const float qv = __uint_as_float((unsigned)(unsigned short)qr[d0][e] << 16); qsq += qv * qv; }
        { auto rr = __builtin_amdgcn_permlane32_swap(__float_as_uint(qsq), __float_as_uint(qsq), false, false); qsq = __uint_as_float(rr[0]) + __uint_as_float(rr[1]); }
#pragma unroll
        for (int o_ = 1; o_ < 64; o_ <<= 1) { kmx = fmaxf(kmx, __builtin_bit_cast(float, __builtin_amdgcn_ds_bpermute((lane ^ o_) << 2, __builtin_bit_cast(int, kmx))));
                                              qsq = fmaxf(qsq, __builtin_bit_cast(float, __builtin_amdgcn_ds_bpermute((lane ^ o_) << 2, __builtin_bit_cast(int, qsq)))); }
        if (lane == 0) { sc8[8 + wid] = kmx; sc8[16 + wid] = qsq; }
        __syncthreads();
        {   float km = sc8[8], qmx = sc8[16];
#pragma unroll
            for (int w = 1; w < NW; ++w) { km = fmaxf(km, sc8[8 + w]); qmx = fmaxf(qmx, sc8[16 + w]); }
            const float G = 2.04f * sqrtf(km * qmx) + THR / SCALE;
            auto tabv = [&](int s_) { const unsigned long long t_ = cs[s_]; float r_; const float a_ = __uint_as_float((unsigned)t_ << 16), b_ = __uint_as_float((unsigned)t_ & 0xffff0000u), c_ = __uint_as_float((unsigned)(t_ >> 32) << 16);
                asm("v_add_f32_e32 %0, %1, %2\n\tv_add_f32_e32 %0, %0, %3" : "=&v"(r_) : "v"(a_), "v"(b_), "v"(c_)); return r_; };
            const float v0 = tabv(cur.P0);
            const int jt = lane;
            bool skip = false;
            if (jt < j_hi) skip = (G + tabv(KVBLK * jt + KVBLK - 1) - v0) * (1.4426950408889634f * SCALE) < -160.f;
            const unsigned long long bal = __builtin_amdgcn_ballot_w64(skip);
            int nskip = (~bal == 0ull) ? 64 : __builtin_ctzll(~bal);
            nskip &= ~1;
            if (nskip > j_hi - 4) nskip = (j_hi - 4) & ~1;
            if (nskip < 0) nskip = 0;
            j_lo = __builtin_amdgcn_readfirstlane(nskip);
            {
                const float vw = tabv(qlo); bool skw = false;
                if (jt < j_hi) skw = (G + tabv(KVBLK * jt + KVBLK - 1) - vw) * (1.4426950408889634f * SCALE) < -160.f;
                const unsigned long long bw = __builtin_amdgcn_ballot_w64(skw);
                jw_lo = __builtin_amdgcn_readfirstlane((~bw == 0ull) ? 64 : __builtin_ctzll(~bw));
            }
        }
        SLOAD_H(Kh, Vh, KBASE(0), RS);
    }
    const int NT = j_hi - j_lo;
    if constexpr (MODE == 2) { if (tid < TABN) ((float*)cs)[tid] = cur.aux[tid]; }
    VMW(); SWRITE_HV(0); SWRITE_HK(0);
    __syncthreads();
    float m_reg = -1e30f, l_reg = 0; f32x16 o[4] = {};
#define RESC(a) do { if (__any((a) < 1.f)) { if (hi == 0) al_l[r32] = (a); asm volatile("s_waitcnt lgkmcnt(0)" ::: "memory");              \
                     for (int d_ = 0; d_ < 4; ++d_) for (int r = 0; r < 16; ++r) o[d_][r] *= al_l[crow(r, hi)]; } } while (0)
#define ACT(t) (KBASE(t) <= qlo + QBLK - 1 && KBASE(t) + KVBLK - 1 >= qlo - W + 1 && j_lo + (t) >= jw_lo)
#define MASKT(P0_, P1_, t) do { const int kb_ = KBASE(t); \
        if constexpr (MODE == 2) { bias_mask_tile(P0_, P1_, qm - kb_, (unsigned)W, (const float*)cs); } \
        else { if (kb_ + KVBLK - 1 > qlo || kb_ <= qlo + QBLK - 1 - W) mask_tile(P0_, P1_, qm - kb_, (unsigned)W); } } while (0)
#define CSK(t) (cs + KBASE(t) + r32)
    const unsigned long long* const qx = cs + cur.P0 + wid * QBLK + r32;
    if constexpr (MODE == 1 || PIPE2) {
    int vs_prev = 0, vs_cur = 0, vs_next = SHM_V;
#define ROTV() do { vs_prev = vs_cur; vs_cur = vs_next; vs_next = (vs_next == (NVS - 1) * SHM_V) ? 0 : vs_next + SHM_V; } while (0)
#define STAGE_BAR(t, BUF) do { \
        if ((t) + 1 < NT) { VMW(); SWRITE_HK((BUF) ^ 1); SWRITE_HV(vs_next); } \
        asm volatile("s_waitcnt vmcnt(0) lgkmcnt(0)\n\ts_barrier" ::: "memory"); \
        if ((t) + 2 < NT) { SLOAD_H(Kh, Vh, KBASE((t) + 2), RS); } SBAR(); ROTV(); } while (0)
    f32x16 pA0, pA1, pB0, pB1; float mnA, mnB, alA, alB; bf16x8 pa0, pa1, pa2, pa3;
    if (NT > 1) { SLOAD_H(Kh, Vh, KBASE(1), RS); } SBAR();
    qkt<0, SK, MODE>(pA0, pA1, kba, r32, hi, qr, ACT(0), CSK(0), qx);
    if (!SK || ACT(0)) MASKT(pA0, pA1, 0);
    partialSM(pA0, pA1, m_reg, mnA, alA);
    STAGE_BAR(0, 0);
#define HALF_STEP(PX0, PX1, mnX, alX, PY0, PY1, alY, t, KB) do { \
        SBAR(); qkt<KB, SK, MODE>(PX0, PX1, kba, r32, hi, qr, ACT(t), CSK(t), qx); \
        finishSM(PY0, PY1, alY, l_reg, pa0, pa1, pa2, pa3); SBAR(); \
        pv_tile<0, SK>(o, vb0 + vs_prev, pa0, pa1, pa2, pa3, ACT((t) - 1)); \
        if (!SK || ACT(t)) MASKT(PX0, PX1, (t)); partialSM(PX0, PX1, m_reg, mnX, alX); \
        RESC(alX); \
        STAGE_BAR(t, KB); } while (0)
    for (int t = 1; t + 1 < NT; t += 2) {
        HALF_STEP(pB0, pB1, mnB, alB, pA0, pA1, alA, t, 1);
        HALF_STEP(pA0, pA1, mnA, alA, pB0, pB1, alB, t + 1, 0);
    }
    HALF_STEP(pB0, pB1, mnB, alB, pA0, pA1, alA, NT - 1, 1);
    finishSM(pB0, pB1, alB, l_reg, pa0, pa1, pa2, pa3); SBAR();
    pv_tile<0, SK>(o, vb0 + vs_prev, pa0, pa1, pa2, pa3, ACT(NT - 1));
#undef HALF_STEP
#undef STAGE_BAR
#undef ROTV
    } else {
    const bool grpB = wid >= 4;
    int vs_cur = 0, vs_next = SHM_V;
    bf16x8 u_v0, u_v1, u_k0, u_k1;
#define SLOAD_U(Kp, Vp, k0, rs_) do { u_v0 = load8(ROW(Vp, k0, 0, rs_)); u_v1 = load8(ROW(Vp, k0, 32, rs_)); u_k0 = load8(ROW(Kp, k0, 0, rs_)); u_k1 = load8(ROW(Kp, k0, 32, rs_)); } while (0)
#define SWRITE_U(bf, off_) do { *(bf16x8*)(K_lds + (bf) * SHM_K + kws) = u_k0; *(bf16x8*)(K_lds + (bf) * SHM_K + kws + 32 * 256) = u_k1; \
        *(bf16x8*)(V_lds + (off_) + vst0) = u_v0; *(bf16x8*)(V_lds + (off_) + vst1) = u_v1; } while (0)
#define STAGE_BAR(t, BUF) do { \
        if ((t) + 1 < NT) { if ((t) + 2 < NT) asm volatile("s_waitcnt vmcnt(4)" ::: "memory"); else asm volatile("s_waitcnt vmcnt(0)" ::: "memory"); \
            if ((BUF) == 0) { SWRITE_U(1, vs_next); } else { SWRITE_HK(0); SWRITE_HV(vs_next); } } \
        asm volatile("s_waitcnt lgkmcnt(0)\n\ts_barrier" ::: "memory"); \
        if ((t) + 3 < NT) { if ((BUF) == 0) { SLOAD_U(Kh, Vh, KBASE((t) + 3), RS); } else { SLOAD_H(Kh, Vh, KBASE((t) + 3), RS); } } SBAR(); } while (0)
#define TILE(t, BUF) do { \
        const bool act_ = !SK || ACT(t); bf16x8 pa0, pa1, pa2, pa3; \
        if (act_) { f32x16 p0, p1; float mn, al; \
            qkt<BUF, false, MODE>(p0, p1, kba, r32, hi, qr, true, CSK(t), qx); \
            MASKT(p0, p1, t); partialSM(p0, p1, m_reg, mn, al); RESC(al); \
            finishSM(p0, p1, al, l_reg, pa0, pa1, pa2, pa3); SBAR(); } \
        if (grpB) STAGE_BAR(t, BUF); \
        if (act_) { pv_tile<0, false>(o, vb0 + vs_cur, pa0, pa1, pa2, pa3, true); SBAR(); } \
        if (!grpB) STAGE_BAR(t, BUF); \
        vs_cur = vs_next; vs_next = (vs_next == (NVS - 1) * SHM_V) ? 0 : vs_next + SHM_V; } while (0)
    if (NT > 1) { SLOAD_U(Kh, Vh, KBASE(1), RS); } SBAR();
    if (NT > 2) { SLOAD_H(Kh, Vh, KBASE(2), RS); } SBAR();
    for (int t = 0; t < NT; t += 2) { TILE(t, 0); TILE(t + 1, 1); }
#undef SLOAD_U
#undef SWRITE_U
#undef STAGE_BAR
    }
    {
        int tid2 = wave_u * 64 + fresh_lane(); asm volatile("" : "+v"(tid2));
        const int r32e = tid2 & 31, hie = (tid2 >> 5) & 1;
        if (hie == 0) li_l[r32e] = l_reg; asm volatile("s_waitcnt lgkmcnt(0)" ::: "memory");
        float rli[16];
#pragma unroll
        for (int r = 0; r < 16; ++r) rli[r] = __builtin_amdgcn_rcpf(li_l[crow(r, hie)]);
        char* Ow = (char*)(cur.O + (size_t)(cur.P0 + wid * QBLK) * rs);
        const unsigned ooff = (unsigned)(4 * hie * rs + r32e) * 2u;
#pragma unroll
        for (int r = 0; r < 16; ++r) { const unsigned orow = (unsigned)(((r & 3) + 8 * (r >> 2)) * rs) * 2u;
#pragma unroll
            for (int d0 = 0; d0 < 4; ++d0) { const float v = o[d0][r] * rli[r];
                const float vn = __builtin_bit_cast(float, __builtin_amdgcn_update_dpp(0, __builtin_bit_cast(int, v), 0xB1, 0xF, 0xF, false));
                if ((r32e & 1) == 0) *(unsigned*)(Ow + ooff + orow + d0 * 64) = cvtpk(v, vn); } }
        if constexpr (MODE == 2) { if (hie == 0) cur.L[(size_t)(cur.P0 + wid * QBLK + r32e) * (RS / 128)] = m_reg * SCALE + __logf(l_reg); }
    }
    __syncthreads();
#undef RESC
#undef KBASE
#undef ACT
#undef MASKT
#undef CSK
#undef TILE
}
#undef ROW
#undef VMW
#undef SLOAD_H
#undef SWRITE_HK
#undef SWRITE_HV
#undef SWRITE_H
#undef KSWZ
#undef KRD
#undef SB_ALU
#undef SBAR
}
namespace cg = cooperative_groups;
constexpr int NWAVES = 8;
constexpr int BATCH = 4, SEQ = 4096, DM = 2048, DEPTH = 2, NHF = 8, HD = 128, DH = 1024, NIN = 6152, DFF = 8192;
constexpr int M = BATCH * SEQ;
constexpr int NQKV = 6 * DH;
constexpr float NORM_EPS = 1e-6f;
constexpr size_t MiB = 1u << 20;
constexpr size_t WS_LF = 1 * MiB;
constexpr size_t WS_BT = 1 * MiB + 768 * 1024;
constexpr size_t WS_LSE = 2 * MiB;
constexpr size_t WS_KSQ = 3 * MiB + 512 * 1024;
constexpr size_t WS_WIN = 4 * MiB, WS_WOUT = 28 * MiB, WS_W1 = 36 * MiB, WS_W2 = 68 * MiB;
constexpr size_t WS_XN = 100 * MiB;
constexpr size_t WS_QKV = 164 * MiB;
constexpr size_t WS_OP = 356 * MiB;
constexpr size_t WS_YA = 452 * MiB;
constexpr size_t WS_H = 164 * MiB;
constexpr size_t WS_D1 = 420 * MiB;
constexpr size_t WS_END = 484 * MiB;
constexpr int LDS_BYTES = 147456;

#define GAS __attribute__((address_space(1)))
#define LAS __attribute__((address_space(3)))
typedef unsigned short bf16r;
typedef unsigned v4u __attribute__((ext_vector_type(4)));
typedef unsigned v2u __attribute__((ext_vector_type(2)));
typedef float f32x4 __attribute__((ext_vector_type(4)));
#define LDS_WAIT() asm volatile("s_waitcnt lgkmcnt(0)" ::: "memory")
__device__ __forceinline__ unsigned f2bf(float f) { unsigned u = __builtin_bit_cast(unsigned, f); return (u + 0x7fffu + ((u >> 16) & 1u)) >> 16; }
__device__ __forceinline__ unsigned pk2(float lo, float hi) { return f2bf(lo) | (f2bf(hi) << 16); }
__device__ __forceinline__ float bf2f(unsigned short h) { return __builtin_bit_cast(float, (unsigned)h << 16); }
__device__ __forceinline__ float wave_sum(float v, int lane) {
#pragma unroll
    for (int o = 1; o < 64; o <<= 1) v += __builtin_bit_cast(float, __builtin_amdgcn_ds_bpermute((lane ^ o) << 2, __builtin_bit_cast(int, v)));
    return v;
}

#define XB_TMO      128
#define XB_XCNT(j)  (256  + 64 * (j))
#define XB_XSUB(j)  (1280 + 64 * (j))
#define XB_XGEN(j)  (2304 + 64 * (j))
#define XB_TOP      3328
#define XB_TOPGEN   3392
#define XCD_BAR_WORDS 3456
#define XB_SPIN_CAP (1u << 18)

__device__ __forceinline__ unsigned xb_ld(unsigned* p)              { return __hip_atomic_load(p, __ATOMIC_RELAXED, __HIP_MEMORY_SCOPE_AGENT); }
__device__ __forceinline__ unsigned xb_add(unsigned* p, unsigned v) { return __hip_atomic_fetch_add(p, v, __ATOMIC_RELAXED, __HIP_MEMORY_SCOPE_AGENT); }
__device__ __forceinline__ unsigned xb_xcc_id() { return (unsigned)__builtin_amdgcn_s_getreg((3 << 11) | 20) & 0xFu; }
#define XB_SPIN(cond, bar) do { unsigned _sp = 0; while (cond) { __builtin_amdgcn_s_sleep(1); \
    if ((++_sp & 255u) == 0u) { if (xb_ld(&(bar)[XB_TMO])) break; if (_sp > XB_SPIN_CAP) { atomicAdd(&(bar)[XB_TMO], 1u); break; } } } } while (0)

struct XcdBarrier {
    unsigned* bar; unsigned x;
    volatile LAS unsigned* st;
};

__device__ __forceinline__ XcdBarrier xcd_barrier_post(unsigned* bar, volatile LAS unsigned* st) {
    XcdBarrier b; b.bar = bar; b.x = xb_xcc_id(); b.st = st;
    if (threadIdx.x == 0) (void)xb_add(&bar[XB_XCNT(b.x)], 1u);
    return b;
}
__device__ __forceinline__ void xcd_barrier_complete(unsigned* bar, unsigned x, unsigned& nloc, unsigned& nx) {
    const unsigned G = gridDim.x * gridDim.y * gridDim.z;
    unsigned sum, cnt, mine, sp = 0u;
    for (;;) {
        sum = 0u; cnt = 0u; mine = 0u;
#pragma unroll
        for (unsigned j = 0; j < 16; ++j) { const unsigned c = xb_ld(&bar[XB_XCNT(j)]); sum += c; cnt += (c > 0u) ? 1u : 0u; mine = (j == x) ? c : mine; }
        if (sum == G) break;
        __builtin_amdgcn_s_sleep(1);
        if ((++sp & 255u) == 0u) { if (xb_ld(&bar[XB_TMO])) break; if (sp > XB_SPIN_CAP) { atomicAdd(&bar[XB_TMO], 1u); break; } }
    }
    nloc = mine > 0u ? mine : 1u; nx = cnt > 0u ? cnt : 1u;
}

__device__ __forceinline__ void xcd_barrier(const XcdBarrier& b, const bool leader  ) {
    asm volatile("s_waitcnt vmcnt(0)" ::: "memory");
    __syncthreads();
    if (leader) {
        unsigned* bar = b.bar;
        __builtin_amdgcn_s_waitcnt(0);
        unsigned nloc = b.st[0], nx = b.st[1];
        if (nloc == 0u) { xcd_barrier_complete(bar, b.x, nloc, nx); b.st[0] = nloc; b.st[1] = nx; }
        const unsigned old = xb_add(&bar[XB_XSUB(b.x)], 1u);
        const unsigned gen = old / nloc;
        if (old + 1u == (gen + 1u) * nloc) {
            __builtin_amdgcn_fence(__ATOMIC_RELEASE, "agent");
            asm volatile("s_waitcnt vmcnt(0)" ::: "memory");
            const unsigned og = xb_add(&bar[XB_TOP], 1u);
            const unsigned tg = og / nx;
            if (og + 1u == (tg + 1u) * nx) xb_add(&bar[XB_TOPGEN], 1u);
            else XB_SPIN(xb_ld(&bar[XB_TOPGEN]) == tg, bar);
            __builtin_amdgcn_fence(__ATOMIC_ACQUIRE, "agent");
            xb_add(&bar[XB_XGEN(b.x)], 1u);
            asm volatile("s_waitcnt vmcnt(0)" ::: "memory");
        } else {
            XB_SPIN(xb_ld(&bar[XB_XGEN(b.x)]) == gen, bar);
            __builtin_amdgcn_fence(__ATOMIC_ACQUIRE, "agent");
            asm volatile("s_waitcnt vmcnt(0)" ::: "memory");
        }
    }
    __syncthreads();
}

__device__ __forceinline__ f32x4 add_bf4(f32x4 v, v2u d) {
    v.x += __builtin_bit_cast(float, d.x << 16); v.y += __builtin_bit_cast(float, d.x & 0xffff0000u);
    v.z += __builtin_bit_cast(float, d.y << 16); v.w += __builtin_bit_cast(float, d.y & 0xffff0000u); return v; }
struct Args { const float* in[12]; float* out; unsigned char* ws; };

__device__ __forceinline__ void transpose_item(const float* W, int K, int ldw, int c0, int N, bf16r* WT, int row_off, LAS float* scr, int item, int lane) {
    const int nblk = N / 32, kb = item / nblk, nb = item % nblk, k0 = 64 * kb, n0 = 32 * nb;
#pragma unroll 8
    for (int i = 0; i < 32; ++i) { const int kk = 2 * i + (lane >> 5); scr[kk * 33 + (lane & 31)] = W[(size_t)(k0 + kk) * ldw + c0 + n0 + (lane & 31)]; }
    LDS_WAIT(); asm volatile("" ::: "memory");
    const int c = lane & 7;
#pragma unroll
    for (int j = 0; j < 4; ++j) { const int n = (lane >> 3) + 8 * j; const LAS float* s = scr + (8 * c) * 33 + n;
        v4u o; o.x = pk2(s[0 * 33], s[1 * 33]); o.y = pk2(s[2 * 33], s[3 * 33]); o.z = pk2(s[4 * 33], s[5 * 33]); o.w = pk2(s[6 * 33], s[7 * 33]);
        *(v4u*)(WT + (size_t)(row_off + n0 + n) * K + k0 + 8 * c) = o; }
    LDS_WAIT(); asm volatile("" ::: "memory");
}

__device__ __forceinline__ int t5_bucket(int dist) {
    if (dist < 16) return dist;
    const int thr[15] = {22, 30, 40, 54, 73, 99, 134, 182, 246, 332, 450, 609, 825, 1117, 1513};
    int b = 16;
#pragma unroll
    for (int i = 0; i < 15; ++i) b += (dist >= thr[i]) ? 1 : 0;
    return b;
}

#ifndef GEMM_WGM
#define GEMM_WGM 4
#endif
#ifndef STAGGER_US
#define STAGGER_US 0
#endif
__device__ __forceinline__ void stagger_start(int bx) {
    const unsigned long long ticks = (unsigned long long)(((bx >> 3) & 3) * STAGGER_US * 100);
    const unsigned long long t0 = __builtin_amdgcn_s_memrealtime();
    while (__builtin_amdgcn_s_memrealtime() - t0 < ticks) __builtin_amdgcn_s_sleep(4);
}
#define PHASE_PTRS() \
    const __attribute__((address_space(4))) Args* ap_ = (const __attribute__((address_space(4))) Args*)__builtin_amdgcn_kernarg_segment_ptr(); asm volatile("" : "+s"(ap_)); \
    unsigned char* const ws = ap_->ws; (void)ws; \
    const float* const x_in = ap_->in[0]; const float* const norm1_g = ap_->in[1]; const float* const w_in = ap_->in[2]; const float* const forget_b = ap_->in[3]; \
    const float* const rel_bias = ap_->in[4]; const float* const ona_g = ap_->in[5]; const float* const onb_g = ap_->in[6]; const float* const w_out = ap_->in[7]; \
    const float* const norm2_g = ap_->in[8]; const float* const w_mlp_in = ap_->in[9]; const float* const w_mlp_out = ap_->in[10]; const float* const final_g = ap_->in[11]; \
    float* const XR = ap_->out; \
    float* const KSQ = (float*)(ws + WS_KSQ); (void)KSQ; \
    float* const LF = (float*)(ws + WS_LF); float* const BT = (float*)(ws + WS_BT); float* const LSE = (float*)(ws + WS_LSE); \
    bf16r* const Win_t = (bf16r*)(ws + WS_WIN); bf16r* const Wout_t = (bf16r*)(ws + WS_WOUT); bf16r* const W1_t = (bf16r*)(ws + WS_W1); bf16r* const W2_t = (bf16r*)(ws + WS_W2); \
    bf16r* const XN = (bf16r*)(ws + WS_XN); bf16r* const QKV = (bf16r*)(ws + WS_QKV); bf16r* const OP = (bf16r*)(ws + WS_OP); bf16r* const YA = (bf16r*)(ws + WS_YA); \
    bf16r* const HB = (bf16r*)(ws + WS_H); bf16r* const D1 = (bf16r*)(ws + WS_D1); \
    (void)x_in; (void)norm1_g; (void)w_in; (void)forget_b; (void)rel_bias; (void)ona_g; (void)onb_g; (void)w_out; (void)norm2_g; (void)w_mlp_in; (void)w_mlp_out; (void)final_g; (void)XR; \
    (void)LF; (void)BT; (void)LSE; (void)Win_t; (void)Wout_t; (void)W1_t; (void)W2_t; (void)XN; (void)QKV; (void)OP; (void)YA; (void)HB; (void)D1
__global__ void __launch_bounds__(NWAVES * 64, 2) hymba_fwd(Args args) {
    extern __shared__ __attribute__((aligned(16))) unsigned char lds[];
    cg::grid_group grid = cg::this_grid();
    const int wave_u = __builtin_amdgcn_readfirstlane((int)threadIdx.x >> 6);
    volatile LAS unsigned* bst = (volatile LAS unsigned*)((LAS unsigned char*)lds + 131072);
    if (threadIdx.x < 2) bst[threadIdx.x] = 0u;
    __syncthreads();
    if (args.ws == nullptr) grid.sync();
    const XcdBarrier xbar = xcd_barrier_post((unsigned*)args.ws, bst);
    const int G = gridDim.x, bx = blockIdx.x;
    const int vcu = (G % 8 == 0) ? (bx % 8) * (G / 8) + bx / 8 : bx;
    const int NGW = G * NWAVES;
#ifdef DIAG
#define STAMP(k) do { if (blockIdx.x == 0 && threadIdx.x == 0) ((unsigned long long*)(args.ws + 512 * 1024))[(k)] = __builtin_amdgcn_s_memrealtime(); } while (0)
#else
#define STAMP(k) do {} while (0)
#endif
#define PHASE_IDS() int tid = wave_u * 64 + fresh_lane(); asm volatile("" : "+v"(tid)); const int lane = tid & 63, wave = wave_u, gw = vcu * NWAVES + wave; (void)lane; (void)gw
    constexpr size_t QSTR = (size_t)M * DH;

    { PHASE_IDS(); PHASE_PTRS();
    for (int i = gw * 64 + lane; i < 3 * 8 * swa::TABN; i += NGW * 64) {
        const int e = i % swa::TABN, h = (i / swa::TABN) % 8, p = i / (swa::TABN * 8), rel = e - swa::TABOFF, dil = (p == 0) ? 1 : (p == 1) ? 4 : 16;
        BT[i] = (rel >= 0 && rel <= 128) ? rel_bias[t5_bucket(rel * dil) * 8 + h] * (1.f / swa::SCALE) : 0.f;
    }
    }

    STAMP(0);
#pragma unroll 1
    for (int l = 0; l < DEPTH; ++l) {
#if PHASES & 1
        for (int rep_ = 0; rep_ < REP0; ++rep_) {
            PHASE_IDS(); PHASE_PTRS();
            LAS float* scr = (LAS float*)(lds) + wave * 4096;
            const float* Wi = w_in + (size_t)l * DM * NIN; const float* Wo = w_out + (size_t)l * DM * DM;
            const float* Wa = w_mlp_in + (size_t)l * DM * DFF; const float* Wb = w_mlp_out + (size_t)l * DFF * DM;
            constexpr int I_S = (DM / 64) * (DH / 32), I_O = (DM / 64) * (DM / 32), I_1 = (DM / 64) * (DFF / 32), I_2 = (DFF / 64) * (DM / 32);
            constexpr int NITEMS = 6 * I_S + I_O + I_1 + I_2;
            for (int it = gw; it < NITEMS; it += NGW) {
                int r = it;
                if (r < 6 * I_S) { const int s = r / I_S; const int c0 = s * DH + (s >= 3 ? 8 : 0); transpose_item(Wi, DM, NIN, c0, DH, Win_t, s * DH, scr, r % I_S, lane); continue; } r -= 6 * I_S;
                if (r < I_O) { transpose_item(Wo, DM, DM, 0, DM, Wout_t, 0, scr, r, lane); continue; } r -= I_O;
                if (r < I_1) { transpose_item(Wa, DM, DFF, 0, DFF, W1_t, 0, scr, r, lane); continue; } r -= I_1;
                transpose_item(Wb, DFF, DM, 0, DM, W2_t, 0, scr, r, lane);
            }
            __syncthreads();
            LAS f32x4* wf = (LAS f32x4*)lds;
            const float* g1 = norm1_g + (size_t)l * DM;
            for (int k = tid; k < DM; k += NWAVES * 64) {
                const float gk = g1[k]; const float* src = Wi + (size_t)k * NIN + 3 * DH;
                const f32x4 a = *(const f32x4*)src, b = *(const f32x4*)(src + 4);
                const int j = k >> 8, ln = (k & 255) >> 2, e = k & 3;
                wf[((j * 4 + e) * 2 + 0) * 64 + ln] = a * gk; wf[((j * 4 + e) * 2 + 1) * 64 + ln] = b * gk;
            }
            __syncthreads();
            const float* fb = forget_b + l * NHF;
            for (int m = gw; m < M; m += NGW) {
                const float* xprev = (l == 0) ? x_in : ((l == 1) ? x_in : XR);
                const f32x4* xr = (const f32x4*)(xprev + (size_t)m * DM) + lane;
                f32x4 v[8]; float ss = 0.f;
#pragma unroll
                for (int j = 0; j < 8; ++j) v[j] = xr[64 * j];
                if (l > 0) {
                    const v2u* dr = (const v2u*)(XN + (size_t)m * DM) + lane; const v2u* er = (const v2u*)(D1 + (size_t)m * DM) + lane; v2u d[8], e[8];
#pragma unroll
                    for (int j = 0; j < 8; ++j) { d[j] = dr[64 * j]; e[j] = er[64 * j]; }
                    f32x4* xw = (f32x4*)(XR + (size_t)m * DM) + lane;
#pragma unroll
                    for (int j = 0; j < 8; ++j) { v[j] = add_bf4(add_bf4(v[j], e[j]), d[j]); xw[64 * j] = v[j]; }
                }
#pragma unroll
                for (int j = 0; j < 8; ++j) ss += (v[j].x * v[j].x + v[j].y * v[j].y) + (v[j].z * v[j].z + v[j].w * v[j].w);
                f32x4 fa = {0.f, 0.f, 0.f, 0.f}, fbv = {0.f, 0.f, 0.f, 0.f};
#pragma unroll
                for (int j = 0; j < 8; ++j) {
#pragma unroll
                    for (int e = 0; e < 4; ++e) { const float xv = v[j][e]; fa += wf[((j * 4 + e) * 2 + 0) * 64 + lane] * xv; fbv += wf[((j * 4 + e) * 2 + 1) * 64 + lane] * xv; }
                    asm volatile("" ::: "memory"); }
                const float rstd = 1.f / sqrtf(wave_sum(ss, lane) * (1.f / DM) + NORM_EPS);
                float f8[8];
#pragma unroll
                for (int e = 0; e < 4; ++e) { f8[e] = wave_sum(fa[e], lane); f8[4 + e] = wave_sum(fbv[e], lane); }
                float fsel = f8[0];
#pragma unroll
                for (int e = 1; e < 8; ++e) fsel = (lane == e) ? f8[e] : fsel;
                if (lane < 8) { const float z = fsel * rstd + fb[lane]; const float ls = fminf(z, 0.f) - __logf(1.f + __expf(-fabsf(z)));
                    LF[((size_t)(m / SEQ) * NHF + lane) * SEQ + (m % SEQ)] = ls; KSQ[((size_t)(m / SEQ) * NHF + lane) * SEQ + (m % SEQ)] = 0.f; }
                const f32x4* gr = (const f32x4*)g1 + lane;
                v2u* o8 = (v2u*)(XN + (size_t)m * DM) + lane;
#pragma unroll
                for (int j = 0; j < 8; ++j) { const f32x4 g = gr[64 * j]; v2u w; w.x = pk2(v[j].x * rstd * g.x, v[j].y * rstd * g.y); w.y = pk2(v[j].z * rstd * g.z, v[j].w * rstd * g.w); o8[64 * j] = w; }
            }
        }
#endif
        xcd_barrier(xbar, wave_u == 0 && fresh_lane() == 0); STAMP(1 + l * 8 + 0);
#if REPSYNC > 1
        for (int rs_ = 0; rs_ < 8; ++rs_) xcd_barrier(xbar, wave_u == 0 && fresh_lane() == 0);
#endif
#if PHASES & 2
        for (int rep_ = 0; rep_ < REP1; ++rep_) {
            PHASE_PTRS();
            pg8::Gemm g{XN, Win_t, M, NQKV, DM}; pg8::StaticOrder S; S.init(M, NQKV, G, bx, GEMM_WGM);
            pg8::EpiQKVn E{QKV, DH, QSTR, KSQ, SEQ};
            pg8::gemm_phase<pg8::EpiQKVn, pg8::StaticOrder, true, true>((LAS unsigned char*)lds, g, S, E, wave_u);
        }
#endif
        xcd_barrier(xbar, wave_u == 0 && fresh_lane() == 0); STAMP(1 + l * 8 + 1);
        {
            PHASE_PTRS();
            const swa::bf16* Qa = (const swa::bf16*)QKV; const swa::bf16* Ka = Qa + QSTR; const swa::bf16* Va = Qa + 2 * QSTR;
            const swa::bf16* Qb = Qa + 3 * QSTR; const swa::bf16* Kb = Qa + 4 * QSTR; const swa::bf16* Vb = Qa + 5 * QSTR;
            unsigned* const qctr = (unsigned*)(ws + 15360) + l;
            volatile LAS int* const qslot = (volatile LAS int*)((LAS unsigned char*)lds + 131072 + 64);
            for (;;) {
                if (wave_u == 0 && fresh_lane() == 0) *qslot = (int)__hip_atomic_fetch_add(qctr, 1u, __ATOMIC_RELAXED, __HIP_MEMORY_SCOPE_AGENT);
                __syncthreads();
                const int it = __builtin_amdgcn_readfirstlane(*qslot);
                if (it >= 512 + 1536) break;
                if (it < 512) {
                    const int bh = it & 31, qb = 15 - (it >> 5), b = bh >> 3, h = bh & 7;
                    const size_t off = (size_t)b * SEQ * DH + h * HD;
                    swa::BlockRef r; r.Q = Qa + off; r.K = Ka + off; r.V = Va + off; r.O = (swa::bf16*)YA + off; r.L = nullptr; r.aux = LF + (size_t)bh * SEQ; r.aux2 = KSQ + (size_t)bh * SEQ;
                    r.P0 = qb * 256; r.skv = SEQ; r.W = 1 << 30; r.pad = 0;
                    swa::swa_block<1, true, DH>(r, (char*)lds, wave_u);
                } else {
                    const int g = it - 512, p = g >> 9, bh = (g >> 4) & 31, j = g & 15, b = bh >> 3, h = bh & 7;
                    const int dil = (p == 0) ? 1 : (p == 1) ? 4 : 16, nbr = 16 / dil, res = j / nbr, blk = j % nbr;
                    const size_t off = ((size_t)b * SEQ + res) * DH + h * HD;
                    swa::BlockRef r; r.Q = Qb + off; r.K = Kb + off; r.V = Vb + off; r.O = (swa::bf16*)OP + (size_t)p * QSTR + off;
                    r.L = LSE + ((size_t)p * M + (size_t)b * SEQ + res) * 8 + h; r.aux = BT + (size_t)(p * 8 + h) * swa::TABN; r.aux2 = nullptr;
                    r.P0 = blk * 256; r.skv = SEQ / dil; r.W = 129; r.pad = 0;
                    if (p == 0) swa::swa_block<2, true, DH>(r, (char*)lds, wave_u);
                    else if (p == 1) swa::swa_block<2, true, DH * 4>(r, (char*)lds, wave_u);
                    else swa::swa_block<2, true, DH * 16>(r, (char*)lds, wave_u);
                }
            }
        }
        xcd_barrier(xbar, wave_u == 0 && fresh_lane() == 0); STAMP(1 + l * 8 + 2);
#if PHASES & 16
        for (int rep_ = 0; rep_ < REP3; ++rep_) {
            PHASE_IDS(); PHASE_PTRS();
            const float* ga = ona_g + (size_t)l * DH; const float* gb = onb_g + (size_t)l * DH;
            for (int m = gw; m < M; m += NGW) {
                const int h = lane >> 3;
                const float l0 = LSE[((size_t)0 * M + m) * 8 + h], l1 = LSE[((size_t)1 * M + m) * 8 + h], l2 = LSE[((size_t)2 * M + m) * 8 + h];
                const float mx = fmaxf(l0, fmaxf(l1, l2)); float a0 = __expf(l0 - mx), a1 = __expf(l1 - mx), a2 = __expf(l2 - mx);
                const float inv = 1.f / (a0 + a1 + a2); a0 *= inv; a1 *= inv; a2 *= inv;
                const v4u* ya = (const v4u*)(YA + (size_t)m * DH) + 2 * lane;
                const v4u* o0 = (const v4u*)(OP + (size_t)m * DH) + 2 * lane; const v4u* o1 = (const v4u*)(OP + QSTR + (size_t)m * DH) + 2 * lane; const v4u* o2 = (const v4u*)(OP + 2 * QSTR + (size_t)m * DH) + 2 * lane;
                float va[16], vb[16]; float sa = 0.f, sb = 0.f;
#pragma unroll
                for (int q = 0; q < 2; ++q) { const v4u ua = ya[q], u0 = o0[q], u1 = o1[q], u2 = o2[q];
#pragma unroll
                    for (int e = 0; e < 4; ++e) {
                        const float alo = __builtin_bit_cast(float, ua[e] << 16), ahi = __builtin_bit_cast(float, ua[e] & 0xffff0000u);
                        const float blo = a0 * __builtin_bit_cast(float, u0[e] << 16) + a1 * __builtin_bit_cast(float, u1[e] << 16) + a2 * __builtin_bit_cast(float, u2[e] << 16);
                        const float bhi = a0 * __builtin_bit_cast(float, u0[e] & 0xffff0000u) + a1 * __builtin_bit_cast(float, u1[e] & 0xffff0000u) + a2 * __builtin_bit_cast(float, u2[e] & 0xffff0000u);
                        va[q * 8 + 2 * e] = alo; va[q * 8 + 2 * e + 1] = ahi; vb[q * 8 + 2 * e] = blo; vb[q * 8 + 2 * e + 1] = bhi;
                        sa += alo * alo + ahi * ahi; sb += blo * blo + bhi * bhi; } }
                const float ra = 1.f / sqrtf(wave_sum(sa, lane) * (1.f / DH) + NORM_EPS), rb = 1.f / sqrtf(wave_sum(sb, lane) * (1.f / DH) + NORM_EPS);
                const f32x4* gar = (const f32x4*)ga + 4 * lane; const f32x4* gbr = (const f32x4*)gb + 4 * lane;
                v4u* oa = (v4u*)(XN + (size_t)m * DM) + 2 * lane; v4u* ob = (v4u*)(XN + (size_t)m * DM + DH) + 2 * lane;
#pragma unroll
                for (int q = 0; q < 2; ++q) { const f32x4 g0 = gar[2 * q], g1 = gar[2 * q + 1], h0 = gbr[2 * q], h1 = gbr[2 * q + 1];
                    v4u wa, wb;
                    wa.x = pk2(va[q * 8 + 0] * ra * g0.x, va[q * 8 + 1] * ra * g0.y); wa.y = pk2(va[q * 8 + 2] * ra * g0.z, va[q * 8 + 3] * ra * g0.w);
                    wa.z = pk2(va[q * 8 + 4] * ra * g1.x, va[q * 8 + 5] * ra * g1.y); wa.w = pk2(va[q * 8 + 6] * ra * g1.z, va[q * 8 + 7] * ra * g1.w);
                    wb.x = pk2(vb[q * 8 + 0] * rb * h0.x, vb[q * 8 + 1] * rb * h0.y); wb.y = pk2(vb[q * 8 + 2] * rb * h0.z, vb[q * 8 + 3] * rb * h0.w);
                    wb.z = pk2(vb[q * 8 + 4] * rb * h1.x, vb[q * 8 + 5] * rb * h1.y); wb.w = pk2(vb[q * 8 + 6] * rb * h1.z, vb[q * 8 + 7] * rb * h1.w);
                    oa[q] = wa; ob[q] = wb; }
            }
        }
#endif
        xcd_barrier(xbar, wave_u == 0 && fresh_lane() == 0); STAMP(1 + l * 8 + 3);
#if PHASES & 32
        {
            PHASE_PTRS();
            pg8::Gemm g{XN, Wout_t, M, DM, DM}; pg8::StaticOrder S; S.init(M, DM, G, bx, GEMM_WGM);
#if REP4 > 1
            { pg8::EpiNull EN; pg8::gemm_phase<pg8::EpiNull, pg8::StaticOrder, true, true>((LAS unsigned char*)lds, g, S, EN, wave_u); }
#endif
            pg8::EpiBf16<0> E{D1, DM, nullptr, 0, 0, 1.f};
            pg8::gemm_phase<pg8::EpiBf16<0>, pg8::StaticOrder, true, true>((LAS unsigned char*)lds, g, S, E, wave_u);
        }
#endif
        xcd_barrier(xbar, wave_u == 0 && fresh_lane() == 0); STAMP(1 + l * 8 + 4);
#if PHASES & 64
        for (int rep_ = 0; rep_ < REP5; ++rep_) {
            PHASE_IDS(); PHASE_PTRS(); const float* xsrc = (l == 0) ? x_in : XR;
            const float* g2 = norm2_g + (size_t)l * DM;
            for (int m = gw; m < M; m += NGW) {
                const f32x4* xr = (const f32x4*)(xsrc + (size_t)m * DM) + lane;
                const v2u* dr = (const v2u*)(D1 + (size_t)m * DM) + lane;
                f32x4 v[8]; v2u d[8]; float ss = 0.f;
#pragma unroll
                for (int j = 0; j < 8; ++j) { v[j] = xr[64 * j]; d[j] = dr[64 * j]; }
#pragma unroll
                for (int j = 0; j < 8; ++j) { v[j] = add_bf4(v[j], d[j]); ss += (v[j].x * v[j].x + v[j].y * v[j].y) + (v[j].z * v[j].z + v[j].w * v[j].w); }
                const float rstd = 1.f / sqrtf(wave_sum(ss, lane) * (1.f / DM) + NORM_EPS);
                const f32x4* gr = (const f32x4*)g2 + lane;
                v2u* o8 = (v2u*)(XN + (size_t)m * DM) + lane;
#pragma unroll
                for (int j = 0; j < 8; ++j) { const f32x4 g = gr[64 * j]; v2u w; w.x = pk2(v[j].x * rstd * g.x, v[j].y * rstd * g.y); w.y = pk2(v[j].z * rstd * g.z, v[j].w * rstd * g.w); o8[64 * j] = w; }
            }
        }
#endif
        xcd_barrier(xbar, wave_u == 0 && fresh_lane() == 0); STAMP(1 + l * 8 + 5);
#if PHASES & 128
        for (int rep_ = 0; rep_ < REP6; ++rep_) {
            PHASE_PTRS();
            pg8::Gemm g{XN, W1_t, M, DFF, DM}; pg8::StaticOrder S; S.init(M, DFF, G, bx, GEMM_WGM);
#if REP6N > 1
            { pg8::EpiNull EN; pg8::gemm_phase<pg8::EpiNull, pg8::StaticOrder, true, true>((LAS unsigned char*)lds, g, S, EN, wave_u); }
#endif
            pg8::EpiBf16<2> E{HB, DFF, nullptr, 0, 0, 1.f};
            pg8::gemm_phase<pg8::EpiBf16<2>, pg8::StaticOrder, true, true>((LAS unsigned char*)lds, g, S, E, wave_u);
        }
#endif
        xcd_barrier(xbar, wave_u == 0 && fresh_lane() == 0); STAMP(1 + l * 8 + 6);
#if PHASES & 256
        {
            PHASE_PTRS();
            pg8::Gemm g{HB, W2_t, M, DM, DFF}; pg8::StaticOrder S; S.init(M, DM, G, bx, GEMM_WGM);
#if REP7 == 2
            { pg8::EpiNull EN; pg8::gemm_phase<pg8::EpiNull, pg8::StaticOrder, true, true>((LAS unsigned char*)lds, g, S, EN, wave_u); }
#endif
            pg8::EpiBf16<0> E{XN, DM, nullptr, 0, 0, 1.f};
            pg8::gemm_phase<pg8::EpiBf16<0>, pg8::StaticOrder, true, true>((LAS unsigned char*)lds, g, S, E, wave_u);
        }
#endif
        xcd_barrier(xbar, wave_u == 0 && fresh_lane() == 0); STAMP(1 + l * 8 + 7);
    }
    { PHASE_IDS(); PHASE_PTRS();
    for (int m = gw; m < M; m += NGW) {
        f32x4* xr = (f32x4*)(XR + (size_t)m * DM) + lane;
        const v2u* dr = (const v2u*)(XN + (size_t)m * DM) + lane; const v2u* er = (const v2u*)(D1 + (size_t)m * DM) + lane;
        f32x4 v[8]; v2u d[8], e[8]; float ss = 0.f;
#pragma unroll
        for (int j = 0; j < 8; ++j) { v[j] = xr[64 * j]; d[j] = dr[64 * j]; e[j] = er[64 * j]; }
#pragma unroll
        for (int j = 0; j < 8; ++j) { v[j] = add_bf4(add_bf4(v[j], e[j]), d[j]); ss += (v[j].x * v[j].x + v[j].y * v[j].y) + (v[j].z * v[j].z + v[j].w * v[j].w); }
        const float rstd = 1.f / sqrtf(wave_sum(ss, lane) * (1.f / DM) + NORM_EPS);
        const f32x4* gr = (const f32x4*)final_g + lane;
#pragma unroll
        for (int j = 0; j < 8; ++j) xr[64 * j] = v[j] * rstd * gr[64 * j];
    }
    }
#ifdef DIAG
    grid.sync(); STAMP(17);
    if (blockIdx.x == 0 && threadIdx.x < 64) {
        __threadfence();
        const float t1 = (float)(TS[DIAG_B1] - TS[DIAG_A1]) * 0.01f, t2 = (float)(TS[DIAG_B2] - TS[DIAG_A2]) * 0.01f;
        if (threadIdx.x == 0) XR[0] = t1;
        for (int i = threadIdx.x; i < 4096; i += 64) XR[64 + i] = t2;
    }
#endif
}

extern "C" void kernel_launch(void* const* d_in, const int* in_sizes, int n_in, void* d_out, int out_size, void* d_ws, size_t ws_size, hipStream_t stream) {
    static int grid = 0;
    if (grid == 0) {
        if (n_in != 12 || out_size != M * DM || ws_size < WS_END) { fprintf(stderr, "kernel_launch: unexpected shapes (n_in %d out %d ws %zu)\n", n_in, out_size, ws_size); grid = -1; return; }
        int dev = 0, cus = 0, per_cu = 0;
        (void)hipGetDevice(&dev); (void)hipDeviceGetAttribute(&cus, hipDeviceAttributeMultiprocessorCount, dev);
        if (hipFuncSetAttribute((const void*)hymba_fwd, hipFuncAttributeMaxDynamicSharedMemorySize, LDS_BYTES) != hipSuccess) { fprintf(stderr, "kernel_launch: hipFuncSetAttribute failed\n"); grid = -1; return; }
        if (hipOccupancyMaxActiveBlocksPerMultiprocessor(&per_cu, (const void*)hymba_fwd, NWAVES * 64, LDS_BYTES) != hipSuccess || per_cu < 1) { fprintf(stderr, "kernel_launch: occupancy query gives %d\n", per_cu); per_cu = 1; }
        (void)hipGetLastError();
        grid = cus * 1;
        if (grid <= 0) grid = 256;
    }
    if (grid < 0) return;
    if (hipMemsetAsync(d_ws, 0, 16384, stream) != hipSuccess) { fprintf(stderr, "kernel_launch: hipMemsetAsync failed\n"); return; }
    Args a{};
    for (int i = 0; i < 12; ++i) a.in[i] = (const float*)d_in[i];
    a.out = (float*)d_out; a.ws = (unsigned char*)d_ws;
    void* kargs[] = {&a};
    hipError_t e = hipLaunchCooperativeKernel((const void*)hymba_fwd, dim3(grid), dim3(NWAVES * 64), kargs, LDS_BYTES, stream);
    if (e != hipSuccess) fprintf(stderr, "kernel_launch: cooperative launch failed: %s (grid %d)\n", hipGetErrorString(e), grid);
}
```
